# Optimizing an MI355X kernel written in HIP

```python
import math
import jax, jax.numpy as jnp
from jax import lax
import numpy as np

D_MODEL = 2048
BATCH = 4
SEQ = 2048
DEPTH = 4

N_EVEN = (DEPTH + 1) // 2
N_ODD = DEPTH // 2
RMS_EPS = 1e-6
ROPE_THETA = 500000.0
NEG_INF = -1e30
MLA_HEADS = 8
MLA_NOPE = 128
MLA_ROPE = 64
MLA_V = 128
Q_LORA = 512
KV_LORA = 256
MLA_QBLOCK = 128
HY_D = 1024
HY_ORDER = 2
HY_SHORT = 3
HY_EMB = 33
HY_FFN = 64
HY_DECAY_PCT_SHORT = 0.3
HY_DECAY_PCT_LONG = 1.5
HY_TARGET = 1e-2
GQA_HEADS = 16
GQA_KV_HEADS = 4
GQA_HEAD_DIM = 128
GQA_ROT = GQA_HEAD_DIM // 4
WINDOW = 128
BAND_BLOCK = 128
D_FF = 4 * D_MODEL
E_IN = Q_LORA + KV_LORA + MLA_ROPE + 3 * HY_D
MIX_EVEN = MLA_HEADS * MLA_V + HY_D
QKV_ODD = (GQA_HEADS + 2 * GQA_KV_HEADS) * GQA_HEAD_DIM

kernel_name = "hybrid_mla_hyena_swa_encoder"


def rms_norm(x, g):
    x32 = x.astype(jnp.float32)
    y = x32 * lax.rsqrt(jnp.mean(x32 * x32, axis=-1, keepdims=True) + RMS_EPS)
    return (y * g.astype(jnp.float32)).astype(x.dtype)


def rotary(x, pos):
    d = x.shape[-1]
    inv = ROPE_THETA ** (-jnp.arange(0, d, 2, dtype=jnp.float32) / d)
    ang = pos[:, None] * inv[None, :]
    cos = jnp.cos(ang)[None, :, None, :]
    sin = jnp.sin(ang)[None, :, None, :]
    x1, x2 = jnp.split(x.astype(jnp.float32), 2, axis=-1)
    return jnp.concatenate([x1 * cos - x2 * sin, x2 * cos + x1 * sin], axis=-1).astype(x.dtype)


def ada_modulation(c, w, b):
    m = jax.nn.silu(c) @ w + b
    shift, scale, gate = jnp.split(m[:, None, :], 3, axis=-1)
    return shift, scale, gate


def mla_attention(q_lat, kv_lat, k_rope, q_norm_g, kv_norm_g, w_uq, w_ukv, pos):
    B, S, _ = q_lat.shape
    q = (rms_norm(q_lat, q_norm_g) @ w_uq).reshape(B, S, MLA_HEADS, MLA_NOPE + MLA_ROPE)
    q_nope, q_rope = q[..., :MLA_NOPE], rotary(q[..., MLA_NOPE:], pos)
    kv = (rms_norm(kv_lat, kv_norm_g) @ w_ukv).reshape(B, S, MLA_HEADS, MLA_NOPE + MLA_V)
    k_nope, v = kv[..., :MLA_NOPE], kv[..., MLA_NOPE:]
    k_rope = rotary(k_rope[:, :, None, :], pos)[:, :, 0, :]
    scale = (MLA_NOPE + MLA_ROPE) ** -0.5
    nb = S // MLA_QBLOCK
    qn_b = q_nope.reshape(B, nb, MLA_QBLOCK, MLA_HEADS, MLA_NOPE).transpose(1, 0, 2, 3, 4)
    qr_b = q_rope.reshape(B, nb, MLA_QBLOCK, MLA_HEADS, MLA_ROPE).transpose(1, 0, 2, 3, 4)

    def block(args):
        qn, qr = args
        s = jnp.einsum('bqhd,bkhd->bhqk', qn, k_nope) + jnp.einsum('bqhr,bkr->bhqk', qr, k_rope)
        p = jax.nn.softmax(s.astype(jnp.float32) * scale, axis=-1).astype(v.dtype)
        return jnp.einsum('bhqk,bkhd->bqhd', p, v)

    o = lax.map(block, (qn_b, qr_b))
    return o.transpose(1, 0, 2, 3, 4).reshape(B, S, MLA_HEADS * MLA_V)


def short_conv(u, w, b):
    S = u.shape[1]
    pad = HY_SHORT // 2
    up = jnp.pad(u, ((0, 0), (pad, pad), (0, 0)))
    y = b
    for j in range(HY_SHORT):
        y = y + up[:, j:j + S] * w[j]
    return y


def hyena_filters(L, w1, b1, w2, b2, w3, b3, freq, w4):
    f32 = jnp.float32
    t = jnp.linspace(0.0, 1.0, L, dtype=f32)[:, None]
    bands = (HY_EMB - 1) // 2
    wpos = 2.0 * math.pi * jnp.arange(L, dtype=f32) / L
    fb = jnp.linspace(1e-4, bands - 1, bands, dtype=f32)
    fw = wpos[:, None] * fb[None, :]
    z = jnp.concatenate([t, jnp.cos(fw), -jnp.sin(fw)], axis=-1)
    fr = freq.astype(f32)
    h = jnp.sin(fr * (z @ w1.astype(f32) + b1.astype(f32)))
    h = jnp.sin(fr * (h @ w2.astype(f32) + b2.astype(f32)))
    h = jnp.sin(fr * (h @ w3.astype(f32) + b3.astype(f32)))
    h = (h @ w4.astype(f32)).reshape(L, HY_ORDER, 2, HY_D)
    max_decay = math.log(HY_TARGET) / HY_DECAY_PCT_SHORT
    min_decay = math.log(HY_TARGET) / HY_DECAY_PCT_LONG
    deltas = jnp.linspace(min_decay, max_decay, HY_D, dtype=f32)
    decay = jnp.exp(-t * jnp.abs(deltas)[None, :])
    h = h * decay[:, None, None, :]
    fwd, bwd = h[:, :, 0], h[:, :, 1]
    k = jnp.concatenate([fwd, jnp.zeros((1, HY_ORDER, HY_D), f32), bwd[:0:-1]], axis=0)
    return k / jnp.sum(jnp.abs(k), axis=0, keepdims=True)


def fft_long_conv(u, k_hat, skip):
    L = u.shape[1]
    u32 = u.astype(jnp.float32)
    u_hat = jnp.fft.rfft(u32, n=2 * L, axis=1)
    y = jnp.fft.irfft(u_hat * k_hat[None], n=2 * L, axis=1)[:, :L]
    return (y + u32 * skip.astype(jnp.float32)).astype(u.dtype)


def hyena_mixer(hy_in, conv_w, conv_b, f_w1, f_b1, f_w2, f_b2, f_w3, f_b3, f_freq, f_w4, hy_skip):
    S = hy_in.shape[1]
    u = short_conv(hy_in, conv_w, conv_b)
    v, x1, x2 = jnp.split(u, 3, axis=-1)
    k = hyena_filters(S, f_w1, f_b1, f_w2, f_b2, f_w3, f_b3, f_freq, f_w4)
    k_hat = jnp.fft.rfft(k, axis=0)
    z = x1 * fft_long_conv(v, k_hat[:, 0], hy_skip[0])
    return x2 * fft_long_conv(z, k_hat[:, 1], hy_skip[1])


def window_gqa(h, w_qkv, sinks, w_o, pos):
    B, S, _ = h.shape
    G = GQA_HEADS // GQA_KV_HEADS
    BB = BAND_BLOCK
    qkv = h @ w_qkv
    q, k, v = jnp.split(qkv, [GQA_HEADS * GQA_HEAD_DIM, (GQA_HEADS + GQA_KV_HEADS) * GQA_HEAD_DIM], axis=-1)
    q = q.reshape(B, S, GQA_HEADS, GQA_HEAD_DIM)
    k = k.reshape(B, S, GQA_KV_HEADS, GQA_HEAD_DIM)
    v = v.reshape(B, S, GQA_KV_HEADS, GQA_HEAD_DIM)
    q = jnp.concatenate([rotary(q[..., :GQA_ROT], pos), q[..., GQA_ROT:]], axis=-1)
    k = jnp.concatenate([rotary(k[..., :GQA_ROT], pos), k[..., GQA_ROT:]], axis=-1)
    nb = S // BB
    q = q.reshape(B, nb, BB, GQA_KV_HEADS, G, GQA_HEAD_DIM)

    def band(t):
        tp = jnp.pad(t, ((0, 0), (BB, BB), (0, 0), (0, 0))).reshape(B, nb + 2, BB, GQA_KV_HEADS, GQA_HEAD_DIM)
        return jnp.concatenate([tp[:, :-2], tp[:, 1:-1], tp[:, 2:]], axis=2)

    kb, vb = band(k), band(v)
    s = jnp.einsum('bnqhgd,bnkhd->bnhgqk', q, kb).astype(jnp.float32) * (GQA_HEAD_DIM ** -0.5)
    qpos = jnp.arange(nb)[:, None] * BB + jnp.arange(BB)[None, :]
    kpos = (jnp.arange(nb)[:, None] - 1) * BB + jnp.arange(3 * BB)[None, :]
    rel = kpos[:, None, :] - qpos[:, :, None]
    valid = (jnp.abs(rel) <= WINDOW) & (kpos[:, None, :] >= 0) & (kpos[:, None, :] < S)
    s = jnp.where(valid[None, :, None, None], s, NEG_INF)
    sink = jnp.broadcast_to(sinks.astype(jnp.float32).reshape(GQA_KV_HEADS, G)[None, None, :, :, None, None],
                            s.shape[:-1] + (1,))
    p = jax.nn.softmax(jnp.concatenate([s, sink], axis=-1), axis=-1)[..., :-1].astype(vb.dtype)
    o = jnp.einsum('bnhgqk,bnkhd->bnqhgd', p, vb).reshape(B, S, GQA_HEADS * GQA_HEAD_DIM)
    return o @ w_o


def setup_inputs(seed: int = 0) -> dict:
    key = jax.random.key(seed)
    ks = iter(jax.random.split(key, 40))
    f32 = jnp.float32

    def nrm(shape, scale):
        return jax.random.normal(next(ks), shape, f32) * scale

    def gain(shape):
        return 1.0 + nrm(shape, 0.01)

    D = D_MODEL
    return {
        "x": nrm((BATCH, SEQ, D), 1.0),
        "c": nrm((BATCH, D), 1.0),
        "ada_mix_w": nrm((DEPTH, D, 3 * D), 0.5 * D ** -0.5),
        "ada_mix_b": nrm((DEPTH, 3 * D), 0.01),
        "norm_mix_g": gain((DEPTH, D)),
        "ada_mlp_w": nrm((DEPTH, D, 3 * D), 0.5 * D ** -0.5),
        "ada_mlp_b": nrm((DEPTH, 3 * D), 0.01),
        "norm_mlp_g": gain((DEPTH, D)),
        "w_mlp_in": nrm((DEPTH, D, D_FF), D ** -0.5),
        "w_mlp_out": nrm((DEPTH, D_FF, D), D_FF ** -0.5),
        "e_w_in": nrm((N_EVEN, D, E_IN), D ** -0.5),
        "e_q_norm_g": gain((N_EVEN, Q_LORA)),
        "e_kv_norm_g": gain((N_EVEN, KV_LORA)),
        "e_w_uq": nrm((N_EVEN, Q_LORA, MLA_HEADS * (MLA_NOPE + MLA_ROPE)), Q_LORA ** -0.5),
        "e_w_ukv": nrm((N_EVEN, KV_LORA, MLA_HEADS * (MLA_NOPE + MLA_V)), KV_LORA ** -0.5),
        "e_conv_w": nrm((N_EVEN, HY_SHORT, 3 * HY_D), HY_SHORT ** -0.5),
        "e_conv_b": nrm((N_EVEN, 3 * HY_D), 0.01),
        "e_f_w1": nrm((N_EVEN, HY_EMB, HY_FFN), HY_EMB ** -0.5),
        "e_f_b1": nrm((N_EVEN, HY_FFN), 0.01),
        "e_f_w2": nrm((N_EVEN, HY_FFN, HY_FFN), HY_FFN ** -0.5),
        "e_f_b2": nrm((N_EVEN, HY_FFN), 0.01),
        "e_f_w3": nrm((N_EVEN, HY_FFN, HY_FFN), HY_FFN ** -0.5),
        "e_f_b3": nrm((N_EVEN, HY_FFN), 0.01),
        "e_f_freq": gain((N_EVEN, HY_FFN)),
        "e_f_w4": nrm((N_EVEN, HY_FFN, HY_ORDER * 2 * HY_D), HY_FFN ** -0.5),
        "e_hy_skip": nrm((N_EVEN, HY_ORDER, HY_D), 0.1),
        "e_w_out": nrm((N_EVEN, MIX_EVEN, D), MIX_EVEN ** -0.5),
        "o_w_qkv": nrm((N_ODD, D, QKV_ODD), D ** -0.5),
        "o_sinks": nrm((N_ODD, GQA_HEADS), 1.0),
        "o_w_o": nrm((N_ODD, GQA_HEADS * GQA_HEAD_DIM, D), (GQA_HEADS * GQA_HEAD_DIM) ** -0.5),
        "final_norm_g": gain((D,)),
    }


def reference(x, c, ada_mix_w, ada_mix_b, norm_mix_g, ada_mlp_w, ada_mlp_b, norm_mlp_g, w_mlp_in, w_mlp_out,
              e_w_in, e_q_norm_g, e_kv_norm_g, e_w_uq, e_w_ukv, e_conv_w, e_conv_b,
              e_f_w1, e_f_b1, e_f_w2, e_f_b2, e_f_w3, e_f_b3, e_f_freq, e_f_w4, e_hy_skip, e_w_out,
              o_w_qkv, o_sinks, o_w_o, final_norm_g):
    S = x.shape[1]
    pos = jnp.arange(S, dtype=jnp.float32)
    split_pts = [Q_LORA, Q_LORA + KV_LORA, Q_LORA + KV_LORA + MLA_ROPE]
    for l in range(DEPTH):
        shift, scale, gate = ada_modulation(c, ada_mix_w[l], ada_mix_b[l])
        h = rms_norm(x, norm_mix_g[l]) * (1.0 + scale) + shift
        if l % 2 == 0:
            i = l // 2
            z = h @ e_w_in[i]
            q_lat, kv_lat, k_rope, hy_in = jnp.split(z, split_pts, axis=-1)
            a = mla_attention(q_lat, kv_lat, k_rope, e_q_norm_g[i], e_kv_norm_g[i], e_w_uq[i], e_w_ukv[i], pos)
            b = hyena_mixer(hy_in, e_conv_w[i], e_conv_b[i], e_f_w1[i], e_f_b1[i], e_f_w2[i], e_f_b2[i],
                            e_f_w3[i], e_f_b3[i], e_f_freq[i], e_f_w4[i], e_hy_skip[i])
            mix = jnp.concatenate([a, b], axis=-1) @ e_w_out[i]
        else:
            i = l // 2
            mix = window_gqa(h, o_w_qkv[i], o_sinks[i], o_w_o[i], pos)
        x = x + gate * mix
        shift, scale, gate = ada_modulation(c, ada_mlp_w[l], ada_mlp_b[l])
        h = rms_norm(x, norm_mlp_g[l]) * (1.0 + scale) + shift
        x = x + gate * (jnp.square(jax.nn.relu(h @ w_mlp_in[l])) @ w_mlp_out[l])
    return rms_norm(x, final_norm_g)
```

```cpp
#include <hip/hip_runtime.h>
#include <cstdio>
#include <cstdint>
#include <cmath>
namespace pg8 {
#define PG8_LAS __attribute__((address_space(3)))
typedef unsigned short bf16_t;
typedef short bf16x8 __attribute__((ext_vector_type(8)));
typedef float f32x4 __attribute__((ext_vector_type(4)));
typedef unsigned u32x4 __attribute__((ext_vector_type(4)));
constexpr int BM = 256, BK = 64, HALF = 128, HTB = HALF * BK * 2  , STAGE_BYTES = 8 * HTB, NXCD = 8, WGM = 8;

__host__ __device__ __forceinline__ int lds_byte(int r, int c) { const int st = (r >> 4) * 2 + (c >> 5), rr = r & 15, cc = c & 31, ob = rr * 64 + cc * 2; return st * 1024 + (ob ^ (((ob >> 9) & 1) << 5)); }
__host__ __device__ __forceinline__ void stage_rc(int b, int& R, int& C) { const int st = b / 1024, sb = b % 1024, swz = sb ^ (((sb >> 9) & 1) << 5); R = (st >> 1) * 16 + swz / 64; C = (st & 1) * 32 + (swz % 64) / 2; }
__host__ __device__ __forceinline__ int perm32(int rho) { const int n = rho >> 4, i = rho & 15; return 8 * (i >> 2) + 4 * n + (i & 3); }

struct Unit { int pm, pn; };
struct Gemm { const bf16_t* A; const bf16_t* Bt; int M, N, K, lda; };

struct StaticOrder {
    int nM, nN, nwg, G, c;
    __host__ __device__ void init(int M, int N, int G_, int c_) { nM = M / BM; nN = N / BM; nwg = nM * nN; G = G_; c = c_; }
    __host__ __device__ bool next(int i, Unit& u) const {
        const long L = (long)i * G + c; if (L >= nwg) return false;
        int wgid = (int)L; { const int q = nwg / NXCD, r = nwg % NXCD, xcd = wgid % NXCD, off = wgid / NXCD; wgid = (xcd < r ? xcd * (q + 1) : r * (q + 1) + (xcd - r) * q) + off; }
        const int nig = WGM * nN, gid = wgid / nig, fm = gid * WGM, gsz = (nM - fm) < WGM ? (nM - fm) : WGM;
        u.pm = fm + ((wgid % nig) % gsz); u.pn = (wgid % nig) / gsz; return true;
    }
    __device__ __forceinline__ void a_ready(const Unit&) const {}
    __device__ __forceinline__ void done(const Unit&) const {}
};

typedef unsigned u32x2 __attribute__((ext_vector_type(2)));
__device__ __forceinline__ unsigned cvt_pk_bf16(float lo, float hi) { unsigned r; asm volatile("v_cvt_pk_bf16_f32 %0, %1, %2" : "=v"(r) : "v"(lo), "v"(hi)); return r; }

template <int ACT> struct EpiBf16 {
    static constexpr bool PERM = true, AFTER_DRAIN = false;
    bf16_t* O; int ldc; const float* rowss; const float* bias; int bstride;
    float inv_n;
    float* sq0; float* sq1;
    const float* rope;
    __device__ __forceinline__ void operator()(const f32x4 (&acc)[2][2][4][2], const Unit& u, int wr, int wc, int fr, int fq) const {
        const int row0 = u.pm * BM + wr * 64 + fr; const int col0 = u.pn * BM + wc * 32 + 8 * fq;
        f32x4 bv[2][2];
        if (rowss) { const float* bp = bias + (size_t)(u.pm >> 3) * bstride + col0;
#pragma unroll
            for (int bj = 0; bj < 2; ++bj) { bv[bj][0] = bias ? *(const f32x4*)(bp + bj * HALF) : (f32x4){0.f, 0.f, 0.f, 0.f}; bv[bj][1] = bias ? *(const f32x4*)(bp + bj * HALF + 4) : (f32x4){0.f, 0.f, 0.f, 0.f}; } }
        float* sqp = nullptr; if (sq0) { if (u.pn < 2) sqp = sq0; else if (u.pn == 2) sqp = sq1; }
        float rr[2][4];
#pragma unroll
        for (int ai = 0; ai < 2; ++ai)
#pragma unroll
            for (int m = 0; m < 4; ++m) rr[ai][m] = rowss ? rowss[row0 + ai * HALF + m * 16] : 1.0f;
#pragma unroll
        for (int ai = 0; ai < 2; ++ai)
#pragma unroll
            for (int m = 0; m < 4; ++m) { float t = __builtin_amdgcn_rsqf(rr[ai][m] * inv_n + 1e-6f); asm volatile("" : "+v"(t)); rr[ai][m] = rowss ? t : 1.0f; }
#pragma unroll
        for (int ai = 0; ai < 2; ++ai)
#pragma unroll
            for (int m = 0; m < 4; ++m) { const int row = row0 + ai * HALF + m * 16; bf16_t* rowp = O + (size_t)row * ldc + col0;
                const float r = rr[ai][m]; float ssq = 0.f;
#pragma unroll
                for (int bj = 0; bj < 2; ++bj) { f32x4 v0 = acc[ai][bj][m][0], v1 = acc[ai][bj][m][1];
                    if (rowss) { v0 = v0 * r + bv[bj][0]; v1 = v1 * r + bv[bj][1]; }
                    if (sqp) ssq += (v0[0] * v0[0] + v0[1] * v0[1]) + (v0[2] * v0[2] + v0[3] * v0[3]) + (v1[0] * v1[0] + v1[1] * v1[1]) + (v1[2] * v1[2] + v1[3] * v1[3]);
                    if (rope && wc == 0 && (u.pn == 8 || u.pn == 9)) {
                        const float* tb = rope + ((size_t)(row & 2047) * 16 + 8 * (fq & 1)) * 2;
                        const f32x4 t0 = *(const f32x4*)(tb), t1 = *(const f32x4*)(tb + 4), t2 = *(const f32x4*)(tb + 8), t3 = *(const f32x4*)(tb + 12);
                        const float cs[8] = {t0[0], t0[2], t1[0], t1[2], t2[0], t2[2], t3[0], t3[2]}, sn[8] = {t0[1], t0[3], t1[1], t1[3], t2[1], t2[3], t3[1], t3[3]};
                        const float sgn = fq < 2 ? -1.0f : 1.0f;
#pragma unroll
                        for (int e = 0; e < 4; ++e) {
                            { auto pr = __builtin_amdgcn_permlane32_swap(__float_as_uint(v0[e]), __float_as_uint(v0[e]), false, false); const float other = __uint_as_float(fq < 2 ? pr[1] : pr[0]); v0[e] = v0[e] * cs[e] + sgn * other * sn[e]; }
                            { auto pr = __builtin_amdgcn_permlane32_swap(__float_as_uint(v1[e]), __float_as_uint(v1[e]), false, false); const float other = __uint_as_float(fq < 2 ? pr[1] : pr[0]); v1[e] = v1[e] * cs[4 + e] + sgn * other * sn[4 + e]; }
                        }
                    }
                    if (ACT == 2) { f32x4 a, b;
#pragma unroll
                        for (int e = 0; e < 4; ++e) { a[e] = fmaxf(v0[e], 0.f); b[e] = fmaxf(v1[e], 0.f); }
                        v0 = a * a; v1 = b * b; }
                    u32x4 w; w.x = cvt_pk_bf16(v0[0], v0[1]); w.y = cvt_pk_bf16(v0[2], v0[3]); w.z = cvt_pk_bf16(v1[0], v1[1]); w.w = cvt_pk_bf16(v1[2], v1[3]);
                    *(u32x4*)(rowp + bj * HALF) = w; }
                if (sqp) { ssq += __builtin_bit_cast(float, __builtin_amdgcn_ds_swizzle(__builtin_bit_cast(int, ssq), 0x401F));
                    { auto pr = __builtin_amdgcn_permlane32_swap(__float_as_uint(ssq), __float_as_uint(ssq), false, false); ssq = __uint_as_float(pr[0]) + __uint_as_float(pr[1]); }
                    if (fq == 0) __hip_atomic_fetch_add(sqp + row, ssq, __ATOMIC_RELAXED, __HIP_MEMORY_SCOPE_AGENT); } }
    }
};
struct EpiResGate {
    static constexpr bool PERM = true, AFTER_DRAIN = false;
    const float* xin; float* xout; const float* gate;
    bf16_t* Hn; const float* ng; const float* nscale; float* nrowss;
    __device__ __forceinline__ void operator()(const f32x4 (&acc)[2][2][4][2], const Unit& u, int wr, int wc, int fr, int fq) const {
        const int b = u.pm >> 3; const float* g = gate + (size_t)b * 6144;
        const int col0 = u.pn * BM + wc * 32 + 8 * fq;
        f32x4 gv[2][2], gs[2][2];
#pragma unroll
        for (int bj = 0; bj < 2; ++bj)
#pragma unroll
            for (int n = 0; n < 2; ++n) { gv[bj][n] = *(const f32x4*)(g + col0 + bj * HALF + n * 4);
                if (Hn) gs[bj][n] = *(const f32x4*)(ng + col0 + bj * HALF + n * 4) * (*(const f32x4*)(nscale + (size_t)b * 6144 + col0 + bj * HALF + n * 4) + 1.0f); }
#pragma unroll
        for (int ai = 0; ai < 2; ++ai)
#pragma unroll
          for (int mp = 0; mp < 2; ++mp) {
            f32x4 xs[2][2][2];
#pragma unroll
            for (int mm = 0; mm < 2; ++mm) { const size_t off = (size_t)(u.pm * BM + ai * HALF + wr * 64 + (2 * mp + mm) * 16 + fr) * 2048 + col0;
#pragma unroll
                for (int bj = 0; bj < 2; ++bj)
#pragma unroll
                    for (int n = 0; n < 2; ++n) xs[mm][bj][n] = *(const f32x4*)(xin + off + bj * HALF + n * 4); }
            asm volatile("" ::: "memory");
#pragma unroll
            for (int mm = 0; mm < 2; ++mm) { const int m = 2 * mp + mm; const int row = u.pm * BM + ai * HALF + wr * 64 + m * 16 + fr; const size_t off = (size_t)row * 2048 + col0; float ss = 0.f;
#pragma unroll
                for (int bj = 0; bj < 2; ++bj) { f32x4 xo[2];
#pragma unroll
                    for (int n = 0; n < 2; ++n) { xo[n] = xs[mm][bj][n] + gv[bj][n] * acc[ai][bj][m][n];
                        *(f32x4*)(xout + off + bj * HALF + n * 4) = xo[n]; }
                    if (Hn) { ss += (xo[0][0] * xo[0][0] + xo[0][1] * xo[0][1]) + (xo[0][2] * xo[0][2] + xo[0][3] * xo[0][3]) + (xo[1][0] * xo[1][0] + xo[1][1] * xo[1][1]) + (xo[1][2] * xo[1][2] + xo[1][3] * xo[1][3]);
                        const f32x4 h0 = xo[0] * gs[bj][0], h1 = xo[1] * gs[bj][1];
                        u32x4 w; w.x = cvt_pk_bf16(h0[0], h0[1]); w.y = cvt_pk_bf16(h0[2], h0[3]); w.z = cvt_pk_bf16(h1[0], h1[1]); w.w = cvt_pk_bf16(h1[2], h1[3]);
                        *(u32x4*)(Hn + off + bj * HALF) = w; } }
                if (Hn) { ss += __builtin_bit_cast(float, __builtin_amdgcn_ds_swizzle(__builtin_bit_cast(int, ss), 0x401F));
                    { auto rr = __builtin_amdgcn_permlane32_swap(__float_as_uint(ss), __float_as_uint(ss), false, false); ss = __uint_as_float(rr[0]) + __uint_as_float(rr[1]); }
                    if (fq == 0) __hip_atomic_fetch_add(nrowss + row, ss, __ATOMIC_RELAXED, __HIP_MEMORY_SCOPE_AGENT); } }
            asm volatile("" ::: "memory");
          }
    }
};

template <class Epi, class Sched, bool ALIGN_EPI = false, bool SP2 = false>
__device__ __forceinline__ void gemm_phase(PG8_LAS unsigned char* lds, const Gemm g, const Sched& S, const Epi& E, int tid_in) {
    int tid_ = tid_in; asm volatile("" : "+v"(tid_));
    const int tid = tid_, wid = __builtin_amdgcn_readfirstlane(tid >> 6), lane = tid & 63, wr = wid >> 2, wc = wid & 3, fr = lane & 15, fq = lane >> 4;
    int K_ = g.K; asm volatile("" : "+s"(K_));
    const int K = K_, nt = K / BK; int lda_ = g.lda ? g.lda : K_; asm volatile("" : "+s"(lda_)); const int lda = lda_;
    unsigned voffA[2], voffB[2];
#pragma unroll
    for (int i = 0; i < 2; ++i) { int R, C; stage_rc(tid * 16 + i * 8192, R, C); const int Rb = Epi::PERM ? ((R & ~31) + perm32(R & 31)) : R;
        voffA[i] = (unsigned)(R * lda + C) * 2u; voffB[i] = (unsigned)(Rb * K + C) * 2u; }
    const size_t kstep = (size_t)(BK * 2);
    const size_t hstep = (size_t)HALF * K * 2;
    const size_t tstep = 2 * hstep; const size_t hstepA = (size_t)HALF * lda * 2, tstepA = 2 * hstepA;
    const unsigned ldsw = (unsigned)wid * 1024u;
    const int aoff = lds_byte(wr * 64 + fr, fq * 8), boff = lds_byte(wc * 32 + fr, fq * 8);
#define PG8_SA(b, h) (((b) * 2 + (h)) * HTB)
#define PG8_SB(b, h) ((4 + (b) * 2 + (h)) * HTB)
#define PG8_STAGE(bufoff, gbase, voff) do { _Pragma("unroll") for (int _i = 0; _i < 2; ++_i) \
        __builtin_amdgcn_global_load_lds((const unsigned*)((const char*)(gbase) + (voff)[_i]), (PG8_LAS unsigned*)(lds + (bufoff) + ldsw + _i * 8192), 16, 0, 0); } while (0)
#define PG8_LDA(dst, b, h) do { _Pragma("unroll") for (int m = 0; m < 4; ++m) _Pragma("unroll") for (int k = 0; k < 2; ++k) dst[m][k] = *(const PG8_LAS bf16x8*)(lds + PG8_SA(b, h) + aoff + m * 2048 + k * 1024); } while (0)
#define PG8_LDB(dst, b, h) do { _Pragma("unroll") for (int n = 0; n < 2; ++n) _Pragma("unroll") for (int k = 0; k < 2; ++k) dst[n][k] = *(const PG8_LAS bf16x8*)(lds + PG8_SB(b, h) + boff + n * 2048 + k * 1024); } while (0)
#define PG8_MMA(ai, bj, At, Bt) do { __builtin_amdgcn_s_setprio(1); _Pragma("unroll") for (int m = 0; m < 4; ++m) _Pragma("unroll") for (int n = 0; n < 2; ++n) _Pragma("unroll") for (int k = 0; k < 2; ++k) \
        acc[ai][bj][m][n] = __builtin_amdgcn_mfma_f32_16x16x32_bf16(Bt[n][k], At[m][k], acc[ai][bj][m][n], 0, 0, 0); __builtin_amdgcn_s_setprio(0); } while (0)
#define PG8_WAIT_V(n) asm volatile("s_waitcnt vmcnt(" #n ")" ::: "memory")
#define PG8_WAIT_L(n) asm volatile("s_waitcnt lgkmcnt(" #n ")" ::: "memory")
#define PG8_BAR __builtin_amdgcn_s_barrier()
#define PG8_SCHED __builtin_amdgcn_sched_barrier(0)
    Unit cur, nxt; int ui = 0;
    if (!S.next(0, cur)) return;
    f32x4 acc[2][2][4][2];
#pragma unroll
    for (int a = 0; a < 2; ++a)
#pragma unroll
        for (int b = 0; b < 2; ++b)
#pragma unroll
            for (int m = 0; m < 4; ++m)
#pragma unroll
                for (int n = 0; n < 2; ++n) acc[a][b][m][n] = (f32x4){0.f, 0.f, 0.f, 0.f};
    bf16x8 At[4][2], B0[2][2], B1[2][2];
    const char* cA = (const char*)g.A + (size_t)cur.pm * tstepA; const char* cB = (const char*)g.Bt + (size_t)cur.pn * tstep;
    S.a_ready(cur);
    if constexpr (SP2) {
        PG8_STAGE(PG8_SB(0, 0), cB, voffB); PG8_STAGE(PG8_SB(0, 1), cB + hstep, voffB); PG8_STAGE(PG8_SA(0, 0), cA, voffA); PG8_STAGE(PG8_SA(0, 1), cA + hstepA, voffA);
        if (wr == 1) PG8_BAR;
        PG8_WAIT_V(2); PG8_BAR;
        PG8_STAGE(PG8_SB(1, 0), cB + kstep, voffB); PG8_STAGE(PG8_SA(1, 0), cA + kstep, voffA); PG8_STAGE(PG8_SB(1, 1), cB + hstep + kstep, voffB);
        PG8_WAIT_V(6); PG8_BAR;
    } else {
        PG8_STAGE(PG8_SB(0, 0), cB, voffB); PG8_STAGE(PG8_SA(0, 0), cA, voffA); PG8_STAGE(PG8_SB(0, 1), cB + hstep, voffB); PG8_STAGE(PG8_SA(0, 1), cA + hstepA, voffA);
        if (wr == 1) PG8_BAR;
        PG8_WAIT_V(4); PG8_BAR;
        PG8_STAGE(PG8_SB(1, 0), cB + kstep, voffB); PG8_STAGE(PG8_SA(1, 0), cA + kstep, voffA); PG8_STAGE(PG8_SB(1, 1), cB + hstep + kstep, voffB);
        PG8_WAIT_V(6); PG8_BAR;
    }
    for (;;) {
        const bool has_next = S.next(ui + 1, nxt);
        const char* nA = has_next ? (const char*)g.A + (size_t)nxt.pm * tstepA : cA; const char* nB = has_next ? (const char*)g.Bt + (size_t)nxt.pn * tstep : cB;
        for (int t = 0; t < nt; t += 2) {
            const bool last = (t == nt - 2);
            const char* a1 = cA + (size_t)(t + 1) * kstep;
            const char* a2 = last ? nA : cA + (size_t)(t + 2) * kstep; const char* b2 = last ? nB : cB + (size_t)(t + 2) * kstep;
            const char* a3 = a2 + kstep; const char* b3 = b2 + kstep;
            if (last && has_next) S.a_ready(nxt);
            if constexpr (SP2) {
            PG8_LDB(B0, 0, 0); PG8_LDB(B1, 0, 1); PG8_SCHED; PG8_LDA(At, 0, 0); PG8_STAGE(PG8_SA(1, 1), a1 + hstepA, voffA);
            PG8_WAIT_V(8); PG8_WAIT_L(0); PG8_BAR; PG8_MMA(0, 0, At, B0); PG8_MMA(0, 1, At, B1); PG8_BAR; PG8_SCHED;
            PG8_LDA(At, 0, 1); PG8_STAGE(PG8_SB(0, 0), b2, voffB); PG8_STAGE(PG8_SB(0, 1), b2 + hstep, voffB); PG8_STAGE(PG8_SA(0, 0), a2, voffA);
            PG8_WAIT_V(8); PG8_WAIT_L(0); PG8_BAR; PG8_MMA(1, 0, At, B0); PG8_MMA(1, 1, At, B1); PG8_BAR; PG8_SCHED;
            PG8_LDB(B0, 1, 0); PG8_LDB(B1, 1, 1); PG8_SCHED; PG8_LDA(At, 1, 0); PG8_STAGE(PG8_SA(0, 1), a2 + hstepA, voffA);
            PG8_WAIT_V(8); PG8_WAIT_L(0); PG8_BAR; PG8_MMA(0, 0, At, B0); PG8_MMA(0, 1, At, B1); PG8_BAR; PG8_SCHED;
            PG8_LDA(At, 1, 1); PG8_STAGE(PG8_SB(1, 0), b3, voffB); PG8_STAGE(PG8_SB(1, 1), b3 + hstep, voffB); PG8_STAGE(PG8_SA(1, 0), a3, voffA);
            PG8_WAIT_V(8); PG8_WAIT_L(0); PG8_BAR; PG8_MMA(1, 0, At, B0); PG8_MMA(1, 1, At, B1); PG8_BAR; PG8_SCHED;
            } else {
            PG8_LDB(B0, 0, 0); PG8_SCHED; PG8_LDA(At, 0, 0); PG8_STAGE(PG8_SA(1, 1), a1 + hstepA, voffA);
            PG8_WAIT_L(8); PG8_BAR; PG8_WAIT_L(0); PG8_MMA(0, 0, At, B0); PG8_BAR; PG8_SCHED;
            PG8_LDB(B1, 0, 1); PG8_STAGE(PG8_SB(0, 0), b2, voffB);
            PG8_BAR; PG8_WAIT_L(0); PG8_MMA(0, 1, At, B1); PG8_BAR;
            PG8_LDA(At, 0, 1); PG8_STAGE(PG8_SA(0, 0), a2, voffA);
            PG8_BAR; PG8_WAIT_L(0); PG8_MMA(1, 0, At, B0); PG8_BAR; PG8_SCHED;
            PG8_STAGE(PG8_SB(0, 1), b2 + hstep, voffB);
            PG8_WAIT_V(6); PG8_BAR; PG8_MMA(1, 1, At, B1); PG8_BAR;
            PG8_LDB(B0, 1, 0); PG8_SCHED; PG8_LDA(At, 1, 0); PG8_STAGE(PG8_SA(0, 1), a2 + hstepA, voffA);
            PG8_WAIT_L(8); PG8_BAR; PG8_WAIT_L(0); PG8_MMA(0, 0, At, B0); PG8_BAR; PG8_SCHED;
            PG8_LDB(B1, 1, 1); PG8_STAGE(PG8_SB(1, 0), b3, voffB);
            PG8_BAR; PG8_WAIT_L(0); PG8_MMA(0, 1, At, B1); PG8_BAR;
            PG8_LDA(At, 1, 1); PG8_STAGE(PG8_SA(1, 0), a3, voffA);
            PG8_BAR; PG8_WAIT_L(0); PG8_MMA(1, 0, At, B0); PG8_BAR; PG8_SCHED;
            PG8_STAGE(PG8_SB(1, 1), b3 + hstep, voffB);
            PG8_WAIT_V(6); PG8_BAR; PG8_MMA(1, 1, At, B1); PG8_BAR;
            }
        }
        if constexpr (ALIGN_EPI) { if (wr == 0) PG8_BAR; }
        if constexpr (!Epi::AFTER_DRAIN) { E(acc, cur, wr, wc, fr, fq); S.done(cur); }
        if (!has_next) break;
#pragma unroll
        for (int a = 0; a < 2; ++a)
#pragma unroll
            for (int b = 0; b < 2; ++b)
#pragma unroll
                for (int m = 0; m < 4; ++m)
#pragma unroll
                    for (int n = 0; n < 2; ++n) acc[a][b][m][n] = (f32x4){0.f, 0.f, 0.f, 0.f};
        cur = nxt; cA = nA; cB = nB; ++ui;
        if constexpr (ALIGN_EPI) { if (wr == 1) PG8_BAR; }
    }
    PG8_WAIT_V(0);
    if constexpr (!ALIGN_EPI) { if (wr == 0) PG8_BAR; }
    PG8_BAR;
    if constexpr (Epi::AFTER_DRAIN) { E.fused(acc, cur, wr, wc, fr, fq, lds, wid, lane); S.done(cur); }
#undef PG8_SA
#undef PG8_SB
#undef PG8_STAGE
#undef PG8_LDA
#undef PG8_LDB
#undef PG8_MMA
#undef PG8_WAIT_V
#undef PG8_WAIT_L
#undef PG8_BAR
#undef PG8_SCHED
}
}

namespace att {
#define ATT_LAS __attribute__((address_space(3)))
typedef unsigned short bf16_t;
typedef short bf16x8 __attribute__((ext_vector_type(8)));
typedef short s16x4 __attribute__((ext_vector_type(4)));
typedef float f32x16 __attribute__((ext_vector_type(16)));
typedef unsigned u32x4 __attribute__((ext_vector_type(4)));
typedef float f32x2 __attribute__((ext_vector_type(2)));
constexpr int SLOT = 40960, OFF_KN = 0, OFF_V = 16384, OFF_KR = 32768, NSLOT = 3, OFF_SCR = NSLOT * SLOT, LDS_BYTES = OFF_SCR + 8 * 256;
#define ATT_SBAR() __builtin_amdgcn_sched_barrier(0)
__device__ __forceinline__ int crow(int r, int hi) { return (r & 3) + 8 * (r >> 2) + 4 * hi; }
__device__ __forceinline__ unsigned cvtpk(float lo, float hi) { unsigned r; asm volatile("v_cvt_pk_bf16_f32 %0, %1, %2" : "=v"(r) : "v"(lo), "v"(hi)); return r; }
__device__ __forceinline__ float bflo(unsigned w) { return __uint_as_float(w << 16); }
__device__ __forceinline__ float bfhi(unsigned w) { return __uint_as_float(w & 0xffff0000u); }
__device__ __forceinline__ int v_rd_base(int lane) { return ((lane & 3) << 3) | (((lane >> 2) & 3) << 6) | (((lane >> 4) & 1) << 5) | (((lane >> 5) & 1) << 8); }
constexpr int v_rd_off(int d0, int ks, int half) { return d0 * 512 + ks * 4096 + half * 2048; }
template <int OFF> __device__ __forceinline__ s16x4 tr_read(int vb) {
  s16x4 r; asm volatile("ds_read_b64_tr_b16 %0, %1 offset:%2" : "=&v"(r) : "v"(vb), "i"(OFF) : "memory"); return r;
}
template <int KS> __device__ __forceinline__ void pv_rd(s16x4 (&l)[4], s16x4 (&h)[4], int vb) {
  l[0] = tr_read<v_rd_off(0, KS, 0)>(vb); h[0] = tr_read<v_rd_off(0, KS, 1)>(vb); l[1] = tr_read<v_rd_off(1, KS, 0)>(vb); h[1] = tr_read<v_rd_off(1, KS, 1)>(vb);
  l[2] = tr_read<v_rd_off(2, KS, 0)>(vb); h[2] = tr_read<v_rd_off(2, KS, 1)>(vb); l[3] = tr_read<v_rd_off(3, KS, 0)>(vb); h[3] = tr_read<v_rd_off(3, KS, 1)>(vb);
}
#define ATT_PK(L, H) (bf16x8){L[0], L[1], L[2], L[3], H[0], H[1], H[2], H[3]}
__device__ __forceinline__ void pv_mm(f32x16 (&o)[4], bf16x8 pa, const s16x4 (&l)[4], const s16x4 (&h)[4]) {
#pragma unroll
  for (int d0 = 0; d0 < 4; ++d0) o[d0] = __builtin_amdgcn_mfma_f32_32x32x16_bf16(pa, ATT_PK(l[d0], h[d0]), o[d0], 0, 0, 0);
}
__device__ __forceinline__ void pv_all(f32x16 (&o)[4], int vb, bf16x8 pa0, bf16x8 pa1, bf16x8 pa2, bf16x8 pa3) {
  s16x4 la[4], ha[4], lb[4], hb[4];
  pv_rd<0>(la, ha, vb); pv_rd<1>(lb, hb, vb);
  asm volatile("s_waitcnt lgkmcnt(8)" ::: "memory"); ATT_SBAR();
  pv_mm(o, pa0, la, ha); ATT_SBAR();
  pv_rd<2>(la, ha, vb);
  asm volatile("s_waitcnt lgkmcnt(8)" ::: "memory"); ATT_SBAR();
  pv_mm(o, pa1, lb, hb); ATT_SBAR();
  pv_rd<3>(lb, hb, vb);
  asm volatile("s_waitcnt lgkmcnt(8)" ::: "memory"); ATT_SBAR();
  pv_mm(o, pa2, la, ha); ATT_SBAR();
  asm volatile("s_waitcnt lgkmcnt(0)" ::: "memory"); ATT_SBAR();
  pv_mm(o, pa3, lb, hb);
}
#undef ATT_PK
__device__ __forceinline__ void rot8(bf16x8& a, bf16x8& b, const f32x2* tab) {
  u32x4 ua = __builtin_bit_cast(u32x4, a), ub = __builtin_bit_cast(u32x4, b); u32x4 oa, ob;
#pragma unroll
  for (int w = 0; w < 4; ++w) {
    const f32x2 cs0 = tab[2 * w], cs1 = tab[2 * w + 1];
    const float a0 = bflo(ua[w]), a1 = bfhi(ua[w]), b0 = bflo(ub[w]), b1 = bfhi(ub[w]);
    oa[w] = cvtpk(a0 * cs0.x - b0 * cs0.y, a1 * cs1.x - b1 * cs1.y);
    ob[w] = cvtpk(b0 * cs0.x + a0 * cs0.y, b1 * cs1.x + a1 * cs1.y);
  }
  a = __builtin_bit_cast(bf16x8, oa); b = __builtin_bit_cast(bf16x8, ob);
}

template <int DQK, int MODE>
__device__ __forceinline__ void attn_unit(ATT_LAS unsigned char* lds, const bf16_t* Qs, int ldq, const bf16_t* Kn, int ldk, const bf16_t* Kr, const bf16_t* Vs, int ldv,
                                          bf16_t* Os, const f32x2* rope, int q0, int t_lo, int t_hi, float C, float thr, const float* sinkp, int tid_in) {
  constexpr int NR = (DQK - 128) / 16, NQ = DQK / 16;
  int tid_ = tid_in; asm volatile("" : "+v"(tid_));
  const int tid = tid_, lane = tid & 63, r32 = lane & 31, hi = lane >> 5; const int wid = __builtin_amdgcn_readfirstlane(tid >> 6);
  const int rowoff = (MODE == 1) ? (wid & 1) * 32 : wid * 32;
  float sinkl2 = 0.f;
  if (MODE == 1) { const int hs = wid >> 1; Qs += hs * 128; Os += hs * 128; sinkl2 = sinkp[hs] * 1.4426950408889634f; }
  ATT_LAS float* scr = (ATT_LAS float*)(lds + OFF_SCR) + wid * 64; ATT_LAS float* al_l = scr; ATT_LAS float* li_l = scr + 32;
  asm volatile("s_waitcnt vmcnt(0) lgkmcnt(0)\n\ts_barrier" ::: "memory");
  int offKn[2], offV[2], offKr = 0;
#pragma unroll
  for (int i = 0; i < 2; ++i) { const int p = 2 * wid + i;
    { const int row = 4 * p + (lane >> 4), c = (lane & 15) ^ (row & 15); offKn[i] = row * ldk + c * 8; }
    { const int sub = 2 * p + (lane >> 5), kk = (sub >> 2) * 8 + ((lane & 31) >> 2), k = (kk & ~0xC) | ((kk & 4) << 1) | ((kk & 8) >> 1), col = (sub & 3) * 32 + (lane & 3) * 8; offV[i] = k * ldv + col; } }
  if (NR > 0) { const int row = 8 * wid + (lane >> 3), c = (lane & 7) ^ ((row >> 1) & 7); offKr = row * 64 + c * 8; }
#define ATT_DMA(t, s) do { const size_t key0_ = (size_t)(t) * 64; ATT_LAS unsigned char* sl_ = lds + (s) * SLOT; \
    _Pragma("unroll") for (int i_ = 0; i_ < 2; ++i_) { \
      __builtin_amdgcn_global_load_lds((const unsigned*)(Kn + key0_ * ldk + offKn[i_]), (ATT_LAS unsigned*)(sl_ + OFF_KN + (2 * wid + i_) * 1024), 16, 0, 0); \
      __builtin_amdgcn_global_load_lds((const unsigned*)(Vs + key0_ * ldv + offV[i_]), (ATT_LAS unsigned*)(sl_ + OFF_V + (2 * wid + i_) * 1024), 16, 0, 0); } \
    if (NR > 0) __builtin_amdgcn_global_load_lds((const unsigned*)(Kr + key0_ * 64 + offKr), (ATT_LAS unsigned*)(sl_ + OFF_KR + wid * 1024), 16, 0, 0); } while (0)
  const int nT = t_hi - t_lo;
  ATT_DMA(t_lo, 0); if (nT > 1) ATT_DMA(t_lo + 1, 1);
  const int qpos = q0 + rowoff + r32;
  bf16x8 qr[NQ];
  { const bf16_t* qrow = Qs + (size_t)qpos * ldq + hi * 8;
#pragma unroll
    for (int d0 = 0; d0 < NQ; ++d0) qr[d0] = *(const bf16x8*)(qrow + d0 * 16);
    if (MODE == 0) { const f32x2* tb = rope + (size_t)qpos * 32 + hi * 8; rot8(qr[8], qr[10], tb); rot8(qr[9], qr[11], tb + 16); }
    else { const f32x2* tb = rope + (size_t)qpos * 16 + hi * 8; rot8(qr[0], qr[1], tb); } }
  float m_reg = -1e30f, l_reg = 0.f; f32x16 o[4];
#pragma unroll
  for (int d = 0; d < 4; ++d) o[d] = f32x16{};
  const int qw = q0 + rowoff;
#define ATT_QKC(P0, P1, SL, CH) do { if ((CH) < 8) { const int off_ = ((2 * (CH) + hi) ^ (r32 & 15)) << 4; const ATT_LAS unsigned char* kb_ = (SL) + OFF_KN + r32 * 256; \
        const bf16x8 b0_ = *(const ATT_LAS bf16x8*)(kb_ + off_), b1_ = *(const ATT_LAS bf16x8*)(kb_ + 8192 + off_); \
        P0 = __builtin_amdgcn_mfma_f32_32x32x16_bf16(b0_, qr[(CH)], P0, 0, 0, 0); P1 = __builtin_amdgcn_mfma_f32_32x32x16_bf16(b1_, qr[(CH)], P1, 0, 0, 0); } \
      else { const int off_ = ((2 * ((CH) - 8) + hi) ^ ((r32 >> 1) & 7)) << 4; const ATT_LAS unsigned char* kb_ = (SL) + OFF_KR + r32 * 128; \
        const bf16x8 b0_ = *(const ATT_LAS bf16x8*)(kb_ + off_), b1_ = *(const ATT_LAS bf16x8*)(kb_ + 4096 + off_); \
        P0 = __builtin_amdgcn_mfma_f32_32x32x16_bf16(b0_, qr[(CH) < NQ ? (CH) : 0], P0, 0, 0, 0); P1 = __builtin_amdgcn_mfma_f32_32x32x16_bf16(b1_, qr[(CH) < NQ ? (CH) : 0], P1, 0, 0, 0); } } while (0)
#define ATT_MASK(P0, P1, KEYLO) do { if (MODE == 1) { const int klo_ = (KEYLO); const bool full_ = (klo_ >= qw + 31 - 128) && (klo_ + 63 <= qw + 128); \
      if (!full_) { const int dq_ = klo_ + 4 * hi - qpos; \
        _Pragma("unroll") for (int r = 0; r < 16; ++r) { const int d_ = dq_ + (r & 3) + 8 * (r >> 2); \
          if (d_ > 128 || d_ < -128) P0[r] = -1e30f; if (d_ + 32 > 128 || d_ + 32 < -128) P1[r] = -1e30f; } } } } while (0)
#define ATT_PK4(P, BASE, OUT) do { unsigned a0_ = cvtpk(P[BASE + 0], P[BASE + 1]), a1_ = cvtpk(P[BASE + 2], P[BASE + 3]);   \
    unsigned b0_ = cvtpk(P[BASE + 4], P[BASE + 5]), b1_ = cvtpk(P[BASE + 6], P[BASE + 7]);                              \
    auto r0_ = __builtin_amdgcn_permlane32_swap(a0_, b0_, false, false); auto r1_ = __builtin_amdgcn_permlane32_swap(a1_, b1_, false, false); \
    u32x4 w_ = {r0_[0], r1_[0], r0_[1], r1_[1]}; OUT = __builtin_bit_cast(bf16x8, w_); } while (0)
#define ATT_XMAX(V) do { auto rr_ = __builtin_amdgcn_permlane32_swap(__float_as_uint(V), __float_as_uint(V), false, false); V = fmaxf(__uint_as_float(rr_[0]), __uint_as_float(rr_[1])); } while (0)
#define ATT_STEP(HASN, SLC, SLN, KEYLON) do { \
    const bool keep_ = __all(pm - m_reg <= thr); \
    const float mn_ = keep_ ? m_reg : fmaxf(m_reg, pm); \
    const float alpha_ = keep_ ? 1.0f : __builtin_amdgcn_exp2f((m_reg - mn_) * C); \
    m_reg = mn_; const float mnC_ = -mn_ * C; float ps_ = 0.f; \
    bf16x8 pa0_, pa1_, pa2_, pa3_; \
    if (HASN) { n0 = f32x16{}; n1 = f32x16{}; } \
    _Pragma("unroll") for (int c_ = 0; c_ < (NQ > 11 ? NQ : 11); ++c_) { \
      ATT_SBAR(); \
      if (HASN && c_ < NQ) ATT_QKC(n0, n1, SLN, c_); \
      if (c_ < 8) { _Pragma("unroll") for (int e_ = 0; e_ < 2; ++e_) { const int r_ = 2 * c_ + e_; \
          a0[r_] = __builtin_amdgcn_exp2f(fmaf(a0[r_], C, mnC_)); a1[r_] = __builtin_amdgcn_exp2f(fmaf(a1[r_], C, mnC_)); ps_ += a0[r_] + a1[r_]; } } \
      else if (c_ == 8) { auto rr_ = __builtin_amdgcn_permlane32_swap(__float_as_uint(ps_), __float_as_uint(ps_), false, false); ps_ = __uint_as_float(rr_[0]) + __uint_as_float(rr_[1]); l_reg = l_reg * alpha_ + ps_; } \
      else if (c_ == 9) { ATT_PK4(a0, 0, pa0_); ATT_PK4(a0, 8, pa1_); } \
      else if (c_ == 10) { ATT_PK4(a1, 0, pa2_); ATT_PK4(a1, 8, pa3_); } \
    } \
    ATT_SBAR(); \
    if (__any(alpha_ < 1.f)) { if (hi == 0) al_l[r32] = alpha_; asm volatile("s_waitcnt lgkmcnt(0)" ::: "memory"); \
      _Pragma("unroll") for (int r = 0; r < 16; ++r) { const float a_ = al_l[crow(r, hi)]; \
        _Pragma("unroll") for (int d = 0; d < 4; ++d) o[d][r] *= a_; } } \
    if (HASN) ATT_MASK(n0, n1, KEYLON); \
    { const int vb_ = (int)(uintptr_t)((SLC) + OFF_V) + v_rd_base(lane); float mx_ = -3.0e38f; \
      s16x4 la_[4], ha_[4], lb_[4], hb_[4]; \
      pv_rd<0>(la_, ha_, vb_); pv_rd<1>(lb_, hb_, vb_); \
      asm volatile("s_waitcnt lgkmcnt(8)" ::: "memory"); ATT_SBAR(); \
      pv_mm(o, pa0_, la_, ha_); if (HASN) { _Pragma("unroll") for (int r = 0; r < 8; ++r) mx_ = fmaxf(mx_, n0[r]); } ATT_SBAR(); \
      pv_rd<2>(la_, ha_, vb_); \
      asm volatile("s_waitcnt lgkmcnt(8)" ::: "memory"); ATT_SBAR(); \
      pv_mm(o, pa1_, lb_, hb_); if (HASN) { _Pragma("unroll") for (int r = 8; r < 16; ++r) mx_ = fmaxf(mx_, n0[r]); } ATT_SBAR(); \
      pv_rd<3>(lb_, hb_, vb_); \
      asm volatile("s_waitcnt lgkmcnt(8)" ::: "memory"); ATT_SBAR(); \
      pv_mm(o, pa2_, la_, ha_); if (HASN) { _Pragma("unroll") for (int r = 0; r < 8; ++r) mx_ = fmaxf(mx_, n1[r]); } ATT_SBAR(); \
      asm volatile("s_waitcnt lgkmcnt(0)" ::: "memory"); ATT_SBAR(); \
      pv_mm(o, pa3_, lb_, hb_); if (HASN) { _Pragma("unroll") for (int r = 8; r < 16; ++r) mx_ = fmaxf(mx_, n1[r]); ATT_XMAX(mx_); pmn = mx_; } ATT_SBAR(); } \
  } while (0)
  f32x16 a0 = f32x16{}, a1 = f32x16{}, n0, n1; float pm, pmn = 0.f;
  asm volatile("s_waitcnt vmcnt(0) lgkmcnt(0)\n\ts_barrier" ::: "memory");
  if (nT > 2) ATT_DMA(t_lo + 2, 2);
#pragma unroll
  for (int c = 0; c < NQ; ++c) ATT_QKC(a0, a1, lds, c);
  ATT_MASK(a0, a1, t_lo * 64);
  { float mx = a0[0];
#pragma unroll
    for (int r = 1; r < 16; ++r) mx = fmaxf(mx, a0[r]);
#pragma unroll
    for (int r = 0; r < 16; ++r) mx = fmaxf(mx, a1[r]);
    ATT_XMAX(mx); pm = mx; }
  int slot = 0;
  for (int jj = 0; jj + 1 < nT; ++jj) {
    ATT_LAS unsigned char* slc = lds + slot * SLOT; const int ns = slot == 2 ? 0 : slot + 1; ATT_LAS unsigned char* sln = lds + ns * SLOT;
    ATT_STEP(1, slc, sln, (t_lo + jj + 1) * 64);
    a0 = n0; a1 = n1; pm = pmn;
    asm volatile("s_waitcnt vmcnt(0) lgkmcnt(0)\n\ts_barrier" ::: "memory");
    if (jj + 3 < nT) ATT_DMA(t_lo + jj + 3, slot);
    slot = ns;
  }
  { ATT_LAS unsigned char* slc = lds + slot * SLOT; ATT_STEP(0, slc, slc, 0); }
#undef ATT_STEP
#undef ATT_XMAX
#undef ATT_PK4
#undef ATT_MASK
#undef ATT_QKC
  float lt = l_reg; if (MODE == 1) lt += __builtin_amdgcn_exp2f(sinkl2 - m_reg * C);
  if (hi == 0) li_l[r32] = lt; asm volatile("s_waitcnt lgkmcnt(0)" ::: "memory");
  bf16_t* Ow = Os + (size_t)(q0 + rowoff) * 2048 + r32;
#pragma unroll
  for (int r = 0; r < 16; ++r) { const int orow = crow(r, hi); const float rl = 1.0f / li_l[orow];
#pragma unroll
    for (int d0 = 0; d0 < 4; ++d0) { const unsigned w = cvtpk(o[d0][r] * rl, 0.f); Ow[(size_t)orow * 2048 + d0 * 32] = (bf16_t)(w & 0xffffu); } }
#undef ATT_DMA
}
}

namespace hy {
#define HY_LAS __attribute__((address_space(3)))
typedef float f32x2 __attribute__((ext_vector_type(2)));
typedef float f32x4 __attribute__((ext_vector_type(4)));
constexpr int OFF_A = 0, OFF_B = 32768, OFF_TW = 65536, NTWC = 2730, OFF_RED = OFF_TW + 22528, LDS_BYTES = OFF_RED + 256;
__device__ __forceinline__ int sw(int i) { return i ^ ((i >> 4) & 31); }
__host__ __device__ constexpr int twb(int lh) { return 2 * ((4096 - (4 << (lh - 1))) / 3); }
__device__ __forceinline__ float fadd_s(float a, float b) { float r; asm("v_add_f32_e32 %0, %1, %2" : "=v"(r) : "v"(a), "v"(b)); return r; }
__device__ __forceinline__ float fsub_s(float a, float b) { float r; asm("v_sub_f32_e32 %0, %1, %2" : "=v"(r) : "v"(a), "v"(b)); return r; }
__device__ __forceinline__ float fmul_s(float a, float b) { float r; asm("v_mul_f32_e32 %0, %1, %2" : "=v"(r) : "v"(a), "v"(b)); return r; }
__device__ __forceinline__ float ffma_s(float a, float b, float c) { float r; asm("v_fma_f32 %0, %1, %2, %3" : "=v"(r) : "v"(a), "v"(b), "v"(c)); return r; }
__device__ __forceinline__ float fnma_s(float a, float b, float c) { float r; asm("v_fma_f32 %0, -%1, %2, %3" : "=v"(r) : "v"(a), "v"(b), "v"(c)); return r; }
__device__ __forceinline__ f32x2 cadd(f32x2 a, f32x2 b) { return (f32x2){fadd_s(a.x, b.x), fadd_s(a.y, b.y)}; }
__device__ __forceinline__ f32x2 csub(f32x2 a, f32x2 b) { return (f32x2){fsub_s(a.x, b.x), fsub_s(a.y, b.y)}; }
__device__ __forceinline__ f32x2 cmul(f32x2 a, f32x2 b) { return (f32x2){fnma_s(a.y, b.y, fmul_s(a.x, b.x)), ffma_s(a.y, b.x, fmul_s(a.x, b.y))}; }
__device__ __forceinline__ f32x2 cmulc(f32x2 a, f32x2 b) { return (f32x2){ffma_s(a.y, b.y, fmul_s(a.x, b.x)), fnma_s(a.x, b.y, fmul_s(a.y, b.x))}; }
#define HY_SYNC() do { asm volatile("s_waitcnt lgkmcnt(0)" ::: "memory"); __builtin_amdgcn_s_barrier(); asm volatile("" ::: "memory"); } while (0)
__device__ __forceinline__ void r4f(f32x2& x0, f32x2& x1, f32x2& x2, f32x2& x3, f32x2 w1, f32x2 w2) {
  const f32x2 a0 = cadd(x0, x2), a2 = cmul(csub(x0, x2), w1), a1 = cadd(x1, x3), t = cmul(csub(x1, x3), w1);
  x0 = cadd(a0, a1); x1 = cmul(csub(a0, a1), w2);
  x2 = (f32x2){fadd_s(a2.x, t.y), fsub_s(a2.y, t.x)};
  x3 = cmul((f32x2){fsub_s(a2.x, t.y), fadd_s(a2.y, t.x)}, w2);
}
__device__ __forceinline__ void r4f_z(f32x2& x0, f32x2& x1, f32x2& x2, f32x2& x3, f32x2 w1, f32x2 w2) {
  const f32x2 a0 = x0, a2 = cmul(x0, w1), a1 = x1, t = cmul(x1, w1);
  x0 = cadd(a0, a1); x1 = cmul(csub(a0, a1), w2);
  x2 = (f32x2){fadd_s(a2.x, t.y), fsub_s(a2.y, t.x)};
  x3 = cmul((f32x2){fsub_s(a2.x, t.y), fadd_s(a2.y, t.x)}, w2);
}
__device__ __forceinline__ void r4i(f32x2& x0, f32x2& x1, f32x2& x2, f32x2& x3, f32x2 w1, f32x2 w2) {
  const f32x2 t1 = cmulc(x1, w2), t3 = cmulc(x3, w2);
  const f32x2 b0 = cadd(x0, t1), b1 = csub(x0, t1), b2 = cmulc(cadd(x2, t3), w1), u = cmulc(csub(x2, t3), w1);
  x0 = cadd(b0, b2); x2 = csub(b0, b2);
  x1 = (f32x2){fsub_s(b1.x, u.y), fadd_s(b1.y, u.x)};
  x3 = (f32x2){fadd_s(b1.x, u.y), fsub_s(b1.y, u.x)};
}
template <int LQ, bool ZPAD> __device__ __forceinline__ void r16_fwd(f32x2 (&x)[16], const HY_LAS f32x2* TW, int pos) {
  constexpr int q = 1 << LQ, lh1 = LQ + 3, lh2 = LQ + 1;
#pragma unroll
  for (int jj = 0; jj < 4; ++jj) { const int p1 = pos + jj * q; const f32x2 w1 = TW[twb(lh1) + p1], w2 = TW[twb(lh1) + 4 * q + p1];
    if (ZPAD) r4f_z(x[jj], x[jj + 4], x[jj + 8], x[jj + 12], w1, w2); else r4f(x[jj], x[jj + 4], x[jj + 8], x[jj + 12], w1, w2); }
  { const f32x2 w1 = TW[twb(lh2) + pos], w2 = TW[twb(lh2) + q + pos];
#pragma unroll
    for (int m = 0; m < 4; ++m) r4f(x[4 * m], x[4 * m + 1], x[4 * m + 2], x[4 * m + 3], w1, w2); }
}
template <int LQ> __device__ __forceinline__ void r16_inv(f32x2 (&x)[16], const HY_LAS f32x2* TW, int pos) {
  constexpr int q = 1 << LQ, lh1 = LQ + 3, lh2 = LQ + 1;
  { const f32x2 w1 = TW[twb(lh2) + pos], w2 = TW[twb(lh2) + q + pos];
#pragma unroll
    for (int m = 0; m < 4; ++m) r4i(x[4 * m], x[4 * m + 1], x[4 * m + 2], x[4 * m + 3], w1, w2); }
#pragma unroll
  for (int jj = 0; jj < 4; ++jj) { const int p1 = pos + jj * q; const f32x2 w1 = TW[twb(lh1) + p1], w2 = TW[twb(lh1) + 4 * q + p1];
    r4i(x[jj], x[jj + 4], x[jj + 8], x[jj + 12], w1, w2); }
}
template <int LQ> __device__ __forceinline__ void grp(int g, int& base, int& pos) { pos = g & ((1 << LQ) - 1); base = ((g >> LQ) << (LQ + 4)) + pos; }
template <int LQ, bool ZPAD> __device__ __forceinline__ void pass_fwd(HY_LAS f32x2* X, const HY_LAS f32x2* TW, int g) {
  int base, pos; grp<LQ>(g, base, pos); f32x2 x[16];
#pragma unroll
  for (int j = 0; j < 16; ++j) x[j] = (ZPAD && j >= 8) ? (f32x2){0.f, 0.f} : X[sw(base + (j << LQ))];
  r16_fwd<LQ, ZPAD>(x, TW, pos);
#pragma unroll
  for (int j = 0; j < 16; ++j) X[sw(base + (j << LQ))] = x[j];
}
template <int LQ, bool HALF> __device__ __forceinline__ void pass_inv(HY_LAS f32x2* X, const HY_LAS f32x2* TW, int g) {
  int base, pos; grp<LQ>(g, base, pos); f32x2 x[16];
#pragma unroll
  for (int j = 0; j < 16; ++j) x[j] = X[sw(base + (j << LQ))];
  r16_inv<LQ>(x, TW, pos);
#pragma unroll
  for (int j = 0; j < (HALF ? 8 : 16); ++j) X[sw(base + (j << LQ))] = x[j];
}
__device__ __forceinline__ float bf2f(unsigned short x) { return __uint_as_float((unsigned)x << 16); }
__device__ __forceinline__ unsigned short f2bf(float f) { unsigned r; asm volatile("v_cvt_pk_bf16_f32 %0, %1, %2" : "=v"(r) : "v"(f), "v"(0.f)); return (unsigned short)(r & 0xffffu); }
__device__ __forceinline__ void load_tw(HY_LAS unsigned char* lds, const f32x2* twg, int tid) {
  HY_LAS f32x2* TW = (HY_LAS f32x2*)(lds + OFF_TW);
#pragma unroll
  for (int j = 0; j < 6; ++j) { const int i = tid + 512 * j; if (i < NTWC) TW[i] = twg[i]; }
}

__device__ __forceinline__ void khat_task(HY_LAS unsigned char* lds, const float* KF, f32x2* KH, int li, int cpair, int tid_in) {
  int tid_ = tid_in; asm volatile("" : "+v"(tid_)); const int tid = tid_;
  const int buf = tid >> 8, g = tid & 255, c = 2 * cpair + buf;
  const float* f0 = KF + ((size_t)li * 4096 + c) * 2048;
  const size_t DS = (size_t)1024 * 2048;
  HY_LAS f32x2* X = (HY_LAS f32x2*)(lds + OFF_A + 32768 * buf); const HY_LAS f32x2* TW = (const HY_LAS f32x2*)(lds + OFF_TW);
  float fv0[8], bv0[8], fv1[8], bv1[8]; float an0 = 0.f, an1 = 0.f;
#pragma unroll
  for (int j = 0; j < 8; ++j) { const int t = g + 256 * j; fv0[j] = f0[t]; bv0[j] = f0[DS + t]; fv1[j] = f0[2 * DS + t]; bv1[j] = f0[3 * DS + t]; }
#pragma unroll
  for (int j = 0; j < 8; ++j) { const int t = g + 256 * j; an0 += fabsf(fv0[j]) + (t >= 1 ? fabsf(bv0[j]) : 0.f); an1 += fabsf(fv1[j]) + (t >= 1 ? fabsf(bv1[j]) : 0.f); }
#define HY_WSUM(an) do { \
  an += __builtin_bit_cast(float, __builtin_amdgcn_update_dpp(0, __builtin_bit_cast(int, an), 0xB1, 0xF, 0xF, true)); \
  an += __builtin_bit_cast(float, __builtin_amdgcn_update_dpp(0, __builtin_bit_cast(int, an), 0x4E, 0xF, 0xF, true)); \
  an += __builtin_bit_cast(float, __builtin_amdgcn_update_dpp(0, __builtin_bit_cast(int, an), 0x141, 0xF, 0xF, true)); \
  an += __builtin_bit_cast(float, __builtin_amdgcn_update_dpp(0, __builtin_bit_cast(int, an), 0x140, 0xF, 0xF, true)); \
  an += __builtin_bit_cast(float, __builtin_amdgcn_ds_swizzle(__builtin_bit_cast(int, an), 0x401F)); \
  { auto rr = __builtin_amdgcn_permlane32_swap(__float_as_uint(an), __float_as_uint(an), false, false); an = __uint_as_float(rr[0]) + __uint_as_float(rr[1]); } } while (0)
  HY_WSUM(an0); HY_WSUM(an1);
#undef HY_WSUM
  HY_LAS float* red = (HY_LAS float*)(lds + OFF_RED);
  if ((tid & 63) == 0) { red[(tid >> 6) * 2] = an0; red[(tid >> 6) * 2 + 1] = an1; }
  HY_SYNC();
  const float tot0 = red[buf * 8] + red[buf * 8 + 2] + red[buf * 8 + 4] + red[buf * 8 + 6], tot1 = red[buf * 8 + 1] + red[buf * 8 + 3] + red[buf * 8 + 5] + red[buf * 8 + 7];
  const float inv0 = 1.0f / (tot0 * 4096.0f), inv1 = 1.0f / (tot1 * 4096.0f);
#pragma unroll
  for (int j = 0; j < 8; ++j) { const int t = g + 256 * j; X[sw(t)] = (f32x2){fv0[j] * inv0, fv1[j] * inv1}; if (t >= 1) X[sw(4096 - t)] = (f32x2){bv0[j] * inv0, bv1[j] * inv1}; }
  if (g == 0) { float z0 = 0.f; asm volatile("" : "+v"(z0)); X[sw(2048)] = (f32x2){z0, z0}; }
  HY_SYNC();
  pass_fwd<8, false>(X, TW, g); HY_SYNC();
  pass_fwd<4, false>(X, TW, g); HY_SYNC();
  pass_fwd<0, false>(X, TW, g); HY_SYNC();
  { f32x4* d0 = (f32x4*)(KH + ((size_t)(li * 2 + 0) * 1024 + c) * 4096 + 16 * g); f32x4* d1 = (f32x4*)(KH + ((size_t)(li * 2 + 1) * 1024 + c) * 4096 + 16 * g);
#pragma unroll
    for (int jp = 0; jp < 8; ++jp) { f32x2 k0[2], k1[2];
#pragma unroll
      for (int e = 0; e < 2; ++e) { const int p = 16 * g + 2 * jp + e; const int fq = (int)(__brev((unsigned)p) >> 20), pp = (int)(__brev((unsigned)((4096 - fq) & 4095)) >> 20);
        const f32x2 z = X[sw(p)], zp = X[sw(pp)];
        k0[e] = (f32x2){0.5f * (z.x + zp.x), 0.5f * (z.y - zp.y)}; k1[e] = (f32x2){0.5f * (z.y + zp.y), 0.5f * (zp.x - z.x)}; }
      d0[jp] = (f32x4){k0[0].x, k0[0].y, k0[1].x, k0[1].y}; d1[jp] = (f32x4){k1[0].x, k1[0].y, k1[1].x, k1[1].y}; } }
  HY_SYNC();
}

__device__ __forceinline__ void hyena_unit(HY_LAS unsigned char* lds, const unsigned short* UT, const f32x2* KH, const float* skip, unsigned short* MIXo, int c0, int tid_in) {
  int tid_ = tid_in; asm volatile("" : "+v"(tid_)); const int tid = tid_;
  const int buf = tid >> 8, g = tid & 255;
  HY_LAS f32x2* X = (HY_LAS f32x2*)(lds + OFF_A + 32768 * buf);
  const HY_LAS f32x2* TW = (const HY_LAS f32x2*)(lds + OFF_TW);
  unsigned W01[16], W23[16];
#pragma unroll
  for (int i = 0; i < 16; ++i) { W01[i] = 0u; W23[i] = 0u; }
  const size_t PART = (size_t)4 * 1024 * 2048, BST = (size_t)1024 * 2048;
  const unsigned short* ub = UT + (size_t)(2 * buf) * BST + g;
  int base0, pos0; grp<0>(g, base0, pos0);
  unsigned vraw[8];
#pragma unroll
  for (int j = 0; j < 8; ++j) vraw[j] = (unsigned)ub[(size_t)c0 * 2048 + 256 * j] | ((unsigned)ub[BST + (size_t)c0 * 2048 + 256 * j] << 16);
#pragma unroll 1
  for (int cc = 0; cc < 4; ++cc) {
    const int c = c0 + cc;
    f32x2 zc[8];
#pragma unroll 1
    for (int o = 0; o < 2; ++o) {
      const float sk = skip[o * 1024 + c];
      f32x2 x[16];
      if (o == 0) {
#pragma unroll
        for (int j = 0; j < 8; ++j) x[j] = (f32x2){__uint_as_float(vraw[j] << 16), __uint_as_float(vraw[j] & 0xffff0000u)};
      } else {
#pragma unroll
        for (int j = 0; j < 8; ++j) x[j] = zc[j];
      }
#pragma unroll
      for (int j = 8; j < 16; ++j) x[j] = (f32x2){0.f, 0.f};
      r16_fwd<8, true>(x, TW, g);
#pragma unroll
      for (int j = 0; j < 16; ++j) X[sw(g + (j << 8))] = x[j];
      HY_SYNC();
      f32x4 kk[8];
      { const f32x4* kp = (const f32x4*)(KH + ((size_t)o * 1024 + c) * 4096 + base0);
#pragma unroll
        for (int j = 0; j < 8; ++j) kk[j] = kp[j]; }
      pass_fwd<4, false>(X, TW, g); HY_SYNC();
      {
#pragma unroll
        for (int j = 0; j < 16; ++j) x[j] = X[sw(base0 + j)];
        r16_fwd<0, false>(x, TW, pos0);
#pragma unroll
        for (int j = 0; j < 8; ++j) { x[2 * j] = cmul(x[2 * j], (f32x2){kk[j][0], kk[j][1]}); x[2 * j + 1] = cmul(x[2 * j + 1], (f32x2){kk[j][2], kk[j][3]}); }
        r16_inv<0>(x, TW, pos0);
#pragma unroll
        for (int j = 0; j < 16; ++j) X[sw(base0 + j)] = x[j]; }
      HY_SYNC();
      unsigned graw[8];
      { const unsigned short* gp = ub + (size_t)(o + 1) * PART + (size_t)c * 2048;
#pragma unroll
        for (int j = 0; j < 8; ++j) graw[j] = (unsigned)gp[256 * j] | ((unsigned)gp[BST + 256 * j] << 16); }
      if (o == 1 && cc < 3) {
#pragma unroll
        for (int j = 0; j < 8; ++j) vraw[j] = (unsigned)ub[(size_t)(c + 1) * 2048 + 256 * j] | ((unsigned)ub[BST + (size_t)(c + 1) * 2048 + 256 * j] << 16);
      }
      pass_inv<4, false>(X, TW, g); HY_SYNC();
#pragma unroll
      for (int j = 0; j < 16; ++j) x[j] = X[sw(g + (j << 8))];
      r16_inv<8>(x, TW, g);
#pragma unroll
      for (int j = 0; j < 8; ++j) {
        const float g0 = __uint_as_float(graw[j] << 16), g1 = __uint_as_float(graw[j] & 0xffff0000u);
        if (o == 0) { zc[j] = (f32x2){g0 * (x[j].x + sk * __uint_as_float(vraw[j] << 16)), g1 * (x[j].y + sk * __uint_as_float(vraw[j] & 0xffff0000u))}; }
        else { const float r0 = g0 * (x[j].x + sk * zc[j].x), r1 = g1 * (x[j].y + sk * zc[j].y);
          const unsigned h0 = f2bf(r0), h1 = f2bf(r1);
          if (cc == 0) { W01[2 * j] = h0; W01[2 * j + 1] = h1; } else if (cc == 1) { W01[2 * j] |= h0 << 16; W01[2 * j + 1] |= h1 << 16; }
          else if (cc == 2) { W23[2 * j] = h0; W23[2 * j + 1] = h1; } else { W23[2 * j] |= h0 << 16; W23[2 * j + 1] |= h1 << 16; } }
      }
      HY_SYNC();
    }
  }
#pragma unroll
  for (int j = 0; j < 8; ++j)
#pragma unroll
    for (int e = 0; e < 2; ++e) { const int s = g + 256 * j, b = 2 * buf + e;
      unsigned long long w = (unsigned long long)W01[2 * j + e] | ((unsigned long long)W23[2 * j + e] << 32);
      *(unsigned long long*)(MIXo + ((size_t)b * 2048 + s) * 2048 + 1024 + c0) = w; }
}
}

constexpr int NWAVES = 8;
#define PG8_SP2 true
#define PG8_ALIGN true
#ifndef MK_MULTI
#define MK_MULTI 0
#endif
constexpr int D = 2048, NB = 4, SEQ = 2048, M = NB * SEQ, DFF = 8192, DEPTH = 4;
constexpr int EIN = 3904, EINP = 4096, QL_W = 512, KVL_W = 256, NQ_MLA = 1536, NKV_MLA = 2048, NQKV = 3072;
constexpr float RMS_EPS = 1e-6f;

constexpr size_t MiB = 1u << 20;
constexpr size_t WS_CTL = 0, CTL_ZERO_BYTES = 4 * MiB;
constexpr size_t CTL_ROWSS_OFF = 64 * 1024;
constexpr size_t CTL_ROWSS2_OFF = 320 * 1024;
constexpr size_t CTL_BIAS7_OFF = 2 * MiB;
constexpr size_t CTL_BIAS1_OFF = 2 * MiB + 512 * 1024;
constexpr size_t CTL_MOD_OFF = 1 * MiB;
constexpr size_t WS_WIN = 4 * MiB;
constexpr size_t WS_WOUT = WS_WIN + 128 * MiB;
constexpr size_t WS_WEIN = WS_WOUT + 128 * MiB;
constexpr size_t WS_WEOUT = WS_WEIN + 32 * MiB;
constexpr size_t WS_WQKV = WS_WEOUT + 16 * MiB;
constexpr size_t WS_WO = WS_WQKV + 24 * MiB;
constexpr size_t WS_WUQ = WS_WO + 16 * MiB;
constexpr size_t WS_WUKV = WS_WUQ + 3 * MiB;
constexpr size_t WS_H = WS_WUKV + 2 * MiB;
constexpr size_t WS_Z = WS_H + 32 * MiB;
constexpr size_t WS_Q = WS_Z + 64 * MiB;
constexpr size_t WS_KV = WS_Q + 24 * MiB;
constexpr size_t WS_KR = WS_KV + 32 * MiB;
constexpr size_t WS_QL = WS_KR + 1 * MiB;
constexpr size_t WS_KVL = WS_QL + 8 * MiB;
constexpr size_t WS_UT = WS_KVL + 4 * MiB;
constexpr size_t WS_MIX = WS_UT + 48 * MiB;
constexpr size_t WS_HID = WS_MIX + 32 * MiB;
constexpr size_t WS_KF = WS_HID + 128 * MiB;
constexpr size_t WS_H3 = WS_KF + 64 * MiB;
constexpr size_t WS_W4T = WS_H3 + 1 * MiB;
constexpr size_t WS_ROPE64 = WS_W4T + 2 * MiB;
constexpr size_t WS_ROPE32 = WS_ROPE64 + 1 * MiB;
constexpr size_t WS_TW = WS_ROPE32 + 1 * MiB;
constexpr size_t WS_KH = WS_TW + 1 * MiB;
constexpr size_t WS_END = WS_KH + 128 * MiB;
constexpr int CW_TMO = 0, CW_BAR = 4096;

constexpr int RING_BYTES = 139264;
constexpr int LDSCTL_OFF = RING_BYTES, MISC_OFF = LDSCTL_OFF + 320;
constexpr int LDS_BYTES = 143360;
static_assert(MISC_OFF + 128 <= LDS_BYTES && att::LDS_BYTES <= RING_BYTES && hy::LDS_BYTES <= RING_BYTES && pg8::STAGE_BYTES <= RING_BYTES, "LDS map");

#define GAS __attribute__((address_space(1)))
#define LAS __attribute__((address_space(3)))
typedef unsigned short bf16;
typedef unsigned v4u __attribute__((ext_vector_type(4)));
typedef unsigned v2u __attribute__((ext_vector_type(2)));
typedef float f32x4 __attribute__((ext_vector_type(4)));
typedef float f32x2 __attribute__((ext_vector_type(2)));
typedef GAS unsigned gu32;
#define RLX_AGENT __ATOMIC_RELAXED, __HIP_MEMORY_SCOPE_AGENT
#define LDS_WAIT() asm volatile("s_waitcnt lgkmcnt(0)" ::: "memory")
#define VM_WAIT() asm volatile("s_waitcnt vmcnt(0)" ::: "memory")
__device__ __forceinline__ unsigned pk2(float lo, float hi) { unsigned r; asm volatile("v_cvt_pk_bf16_f32 %0, %1, %2" : "=v"(r) : "v"(lo), "v"(hi)); return r; }
__device__ __forceinline__ float bflo(unsigned w) { return __uint_as_float(w << 16); }
__device__ __forceinline__ float bfhi(unsigned w) { return __uint_as_float(w & 0xffff0000u); }
__device__ __forceinline__ float wave_sum(float v) {
    v += __builtin_bit_cast(float, __builtin_amdgcn_update_dpp(0, __builtin_bit_cast(int, v), 0xB1, 0xF, 0xF, true));
    v += __builtin_bit_cast(float, __builtin_amdgcn_update_dpp(0, __builtin_bit_cast(int, v), 0x4E, 0xF, 0xF, true));
    v += __builtin_bit_cast(float, __builtin_amdgcn_update_dpp(0, __builtin_bit_cast(int, v), 0x141, 0xF, 0xF, true));
    v += __builtin_bit_cast(float, __builtin_amdgcn_update_dpp(0, __builtin_bit_cast(int, v), 0x140, 0xF, 0xF, true));
    v += __builtin_bit_cast(float, __builtin_amdgcn_ds_swizzle(__builtin_bit_cast(int, v), 0x401F));
    { auto rr = __builtin_amdgcn_permlane32_swap(__float_as_uint(v), __float_as_uint(v), false, false); v = __uint_as_float(rr[0]) + __uint_as_float(rr[1]); }
    return v;
}

#ifndef PROBE_CVT
#define PROBE_CVT 0
#endif
#ifndef PROBE_ADA
#define PROBE_ADA 0
#endif
#ifndef PROBE_TAB
#define PROBE_TAB 0
#endif
#ifndef PROBE_NORM
#define PROBE_NORM 0
#endif
#ifndef PROBE_KF
#define PROBE_KF 0
#endif
#ifndef PROBE_G1
#define PROBE_G1 0
#endif
#ifndef PROBE_E3
#define PROBE_E3 0
#endif
#ifndef PROBE_G3
#define PROBE_G3 0
#endif
#ifndef PROBE_MLA
#define PROBE_MLA 0
#endif
#ifndef PROBE_HY
#define PROBE_HY 0
#endif
#ifndef PROBE_GQA
#define PROBE_GQA 0
#endif
#ifndef PROBE_G5
#define PROBE_G5 0
#endif
#ifndef PROBE_G7
#define PROBE_G7 0
#endif
#ifndef PROBE_G8
#define PROBE_G8 0
#endif
#ifndef PROBE_BAR
#define PROBE_BAR 0
#endif
#ifndef PROBE_KH
#define PROBE_KH 0
#endif
#ifndef PROBE_GK
#define PROBE_GK 0
#endif
#ifndef PROBE_FIN
#define PROBE_FIN 0
#endif
#define REP(n) _Pragma("unroll 1") for (int rep_ = 0; rep_ < 1 + PROBE_##n; ++rep_)
#define XB_TMO      128
#define XB_XCNT(j)  (256  + 64 * (j))
#define XB_XSUB(j)  (1280 + 64 * (j))
#define XB_XGEN(j)  (2304 + 64 * (j))
#define XB_TOP      3328
#define XB_TOPGEN   3392
#define XCD_BAR_WORDS 3456
#define XB_SPIN_CAP (1u << 18)

__device__ __forceinline__ unsigned xb_ld(unsigned* p)              { return __hip_atomic_load(p, __ATOMIC_RELAXED, __HIP_MEMORY_SCOPE_AGENT); }
__device__ __forceinline__ unsigned xb_add(unsigned* p, unsigned v) { return __hip_atomic_fetch_add(p, v, __ATOMIC_RELAXED, __HIP_MEMORY_SCOPE_AGENT); }
__device__ __forceinline__ unsigned xb_xcc_id() { return (unsigned)__builtin_amdgcn_s_getreg((3 << 11) | 20) & 0xFu; }
#define XB_SPIN(cond, bar) do { unsigned _sp = 0; while (cond) { __builtin_amdgcn_s_sleep(1); \
    if ((++_sp & 255u) == 0u) { if (xb_ld(&(bar)[XB_TMO])) break; if (_sp > XB_SPIN_CAP) { atomicAdd(&(bar)[XB_TMO], 1u); break; } } } } while (0)

struct XcdBarrier {
    unsigned* bar; unsigned x;
    volatile LAS unsigned* st;
};

__device__ __forceinline__ XcdBarrier xcd_barrier_post(unsigned* bar, volatile LAS unsigned* st) {
    XcdBarrier b; b.bar = bar; b.x = xb_xcc_id(); b.st = st;
    if (threadIdx.x == 0) (void)xb_add(&bar[XB_XCNT(b.x)], 1u);
    return b;
}
__device__ __forceinline__ void xcd_barrier_complete(unsigned* bar, unsigned x, unsigned& nloc, unsigned& nx) {
    const unsigned G = gridDim.x * gridDim.y * gridDim.z;
    unsigned sum, cnt, mine, sp = 0u;
    for (;;) {
        sum = 0u; cnt = 0u; mine = 0u;
#pragma unroll 1
        for (unsigned j = 0; j < 16; ++j) { const unsigned c = xb_ld(&bar[XB_XCNT(j)]); sum += c; cnt += (c > 0u) ? 1u : 0u; mine = (j == x) ? c : mine; }
        if (sum == G) break;
        __builtin_amdgcn_s_sleep(1);
        if ((++sp & 255u) == 0u) { if (xb_ld(&bar[XB_TMO])) break; if (sp > XB_SPIN_CAP) { atomicAdd(&bar[XB_TMO], 1u); break; } }
    }
    nloc = mine > 0u ? mine : 1u; nx = cnt > 0u ? cnt : 1u;
}

__device__ __forceinline__ void xcd_barrier(const XcdBarrier& b, const bool is_thread0  ) {
    asm volatile("s_waitcnt vmcnt(0)" ::: "memory");
    __syncthreads();
    if (is_thread0) {
        unsigned* bar = b.bar;
        __builtin_amdgcn_s_waitcnt(0);
        unsigned nloc = b.st[0], nx = b.st[1];
        if (nloc == 0u) { xcd_barrier_complete(bar, b.x, nloc, nx); b.st[0] = nloc; b.st[1] = nx; }
        const unsigned old = xb_add(&bar[XB_XSUB(b.x)], 1u);
        const unsigned gen = old / nloc;
        if (old + 1u == (gen + 1u) * nloc) {
            __builtin_amdgcn_fence(__ATOMIC_RELEASE, "agent");
            asm volatile("s_waitcnt vmcnt(0)" ::: "memory");
            const unsigned og = xb_add(&bar[XB_TOP], 1u);
            const unsigned tg = og / nx;
            if (og + 1u == (tg + 1u) * nx) xb_add(&bar[XB_TOPGEN], 1u);
            else XB_SPIN(xb_ld(&bar[XB_TOPGEN]) == tg, bar);
            __builtin_amdgcn_fence(__ATOMIC_ACQUIRE, "agent");
            xb_add(&bar[XB_XGEN(b.x)], 1u);
            asm volatile("s_waitcnt vmcnt(0)" ::: "memory");
        } else {
            XB_SPIN(xb_ld(&bar[XB_XGEN(b.x)]) == gen, bar);
            __builtin_amdgcn_fence(__ATOMIC_ACQUIRE, "agent");
            asm volatile("s_waitcnt vmcnt(0)" ::: "memory");
        }
    }
    __syncthreads();
}

struct Frame {
    LAS unsigned char* lds;
    volatile LAS unsigned* MISC;
    gu32* ctl;
    int tid, lane, wave;
    int vcu, G;
    unsigned char* ws;
};
struct Args { const float* in[31]; float* out; unsigned char* ws; int ph_lo, ph_hi; };

struct CvtD { const float* W; bf16* WT; const float* kscale; const float* shiftp; float* biasp; int K, N, bstride, item; };
__device__ __forceinline__ void cvt_load(const CvtD& d, int lane, f32x4 (&v)[16]) {
    const int nblk = d.N >> 6, kb = d.item / nblk, nb = d.item - kb * nblk, k0 = kb << 6, n0 = nb << 6;
#pragma unroll
    for (int i = 0; i < 16; ++i) v[i] = *(const GAS f32x4*)(d.W + (size_t)(k0 + 4 * i + (lane >> 4)) * d.N + n0 + 4 * (lane & 15));
}
__device__ __forceinline__ void cvt_store(const CvtD& d, LAS float* scr, int lane, const f32x4 (&v)[16]) {
    const int K = d.K, nblk = d.N >> 6, kb = d.item / nblk, nb = d.item - kb * nblk, k0 = kb << 6, n0 = nb << 6;
#pragma unroll
    for (int i = 0; i < 16; ++i) { const int kl = 4 * i + (lane >> 4); f32x4 x = v[i]; if (d.kscale) { const float s = d.kscale[k0 + kl]; x = x * s; }
        LAS float* q = scr + kl * 65 + 4 * (lane & 15); q[0] = x[0]; q[1] = x[1]; q[2] = x[2]; q[3] = x[3]; }
    LDS_WAIT(); asm volatile("" ::: "memory");
    if (d.shiftp) {
        float sh[4], ab[4];
#pragma unroll
        for (int b = 0; b < 4; ++b) { sh[b] = d.shiftp[(size_t)b * 6144 + k0 + lane]; ab[b] = 0.f; }
#pragma unroll
        for (int k = 0; k < 64; ++k) { const float w = scr[k * 65 + lane];
#pragma unroll
            for (int b = 0; b < 4; ++b) ab[b] += __builtin_bit_cast(float, __builtin_amdgcn_readlane(__builtin_bit_cast(int, sh[b]), k)) * w; }
#pragma unroll
        for (int b = 0; b < 4; ++b) __hip_atomic_fetch_add(d.biasp + (size_t)b * d.bstride + n0 + lane, ab[b], __ATOMIC_RELAXED, __HIP_MEMORY_SCOPE_AGENT);
    }
    const int c = lane >> 3;
#pragma unroll
    for (int i = 0; i < 8; ++i) { const int n = (lane & 7) + 8 * i; const LAS float* sp = scr + (8 * c) * 65 + n;
        v4u o; o.x = pk2(sp[0 * 65], sp[1 * 65]); o.y = pk2(sp[2 * 65], sp[3 * 65]); o.z = pk2(sp[4 * 65], sp[5 * 65]); o.w = pk2(sp[6 * 65], sp[7 * 65]);
        *(GAS v4u*)(d.WT + (size_t)(n0 + n) * K + k0 + 8 * c) = o; }
    LDS_WAIT(); asm volatile("" ::: "memory");
}

__device__ __forceinline__ void p0_ada(Frame& F, const Args& a) {
    unsigned char* ws = F.ws;
    const int gw = F.vcu * NWAVES + F.wave, NGW = F.G * NWAVES;
    REP(ADA) {
        LAS float* sc = (LAS float*)(F.lds + F.wave * 8192);
        LAS float* tr = sc + 512;
        float* mod = rep_ == PROBE_ADA ? (float*)(ws + CTL_MOD_OFF) : (float*)(ws + WS_END);
        const float* cin = a.in[1];
        for (int t = gw; t < 8 * 32 * 24; t += NGW) {
            const int aa = t / (32 * 24), r = t - aa * (32 * 24), kc = r / 24, nc = r - kc * 24;
            const int l = aa >> 1, sub = aa & 1;
            const float* Wm = (sub ? a.in[5] : a.in[2]) + (size_t)l * D * 6144;
            const float* bias = (sub ? a.in[6] : a.in[3]) + (size_t)l * 6144;
#pragma unroll
            for (int j = 0; j < 4; ++j) { const int idx = F.lane + 64 * j; const int b = idx & 3, kk = idx >> 2;
                const float x = cin[b * D + kc * 64 + kk]; sc[kk * 4 + b] = x / (1.0f + __expf(-x)); }
            LDS_WAIT(); asm volatile("" ::: "memory");
            f32x4 acc[4];
#pragma unroll
            for (int b = 0; b < 4; ++b) acc[b] = (f32x4){0.f, 0.f, 0.f, 0.f};
            const float* wp = Wm + (size_t)(kc * 64) * 6144 + nc * 256 + 4 * F.lane;
#pragma unroll 1
            for (int k0 = 0; k0 < 64; k0 += 32) {
                f32x4 w[32];
#pragma unroll
                for (int k = 0; k < 32; ++k) w[k] = __builtin_nontemporal_load((const GAS f32x4*)(wp + (size_t)(k0 + k) * 6144));
#pragma unroll
                for (int k = 0; k < 32; ++k) { const f32x4 s = *(const LAS f32x4*)(sc + (k0 + k) * 4);
#pragma unroll
                    for (int b = 0; b < 4; ++b) acc[b] += w[k] * s[b]; } }
            if (kc == 0) { const f32x4 bv = *(const GAS f32x4*)(bias + nc * 256 + 4 * F.lane);
#pragma unroll
                for (int b = 0; b < 4; ++b) acc[b] += bv; }
#pragma unroll
            for (int b = 0; b < 4; ++b) *(LAS f32x4*)(tr + b * 256 + 4 * F.lane) = acc[b];
            LDS_WAIT(); asm volatile("" ::: "memory");
#pragma unroll
            for (int b = 0; b < 4; ++b)
#pragma unroll
                for (int j = 0; j < 4; ++j) { const float v = tr[b * 256 + F.lane + 64 * j];
                    __hip_atomic_fetch_add(mod + ((size_t)aa * 4 + b) * 6144 + nc * 256 + F.lane + 64 * j, v, __ATOMIC_RELAXED, __HIP_MEMORY_SCOPE_AGENT); }
            LDS_WAIT(); asm volatile("" ::: "memory");
        }
    }
}
__device__ __forceinline__ void p0_convert(Frame& F, const Args& a) {
    unsigned char* ws = F.ws;
    const int gw = F.vcu * NWAVES + F.wave, NGW = F.G * NWAVES;
    const float* MODp = (const float*)(ws + CTL_MOD_OFF); float* B7 = (float*)(ws + CTL_BIAS7_OFF); float* B1 = (float*)(ws + CTL_BIAS1_OFF);
    REP(CVT) {
        LAS float* scr = (LAS float*)(F.lds + F.wave * 16640);
        constexpr int I_IN = 32 * 128, I_OUT = 128 * 32, I_EIN = 32 * 61, I_EOUT = 32 * 32, I_QKV = 32 * 48, I_WO = 32 * 32, I_UQ = 8 * 24, I_UKV = 4 * 32;
        constexpr int T0 = 4 * I_IN, T1 = T0 + 4 * I_OUT, T2 = T1 + 2 * I_EIN, T3 = T2 + 2 * I_EOUT, T4 = T3 + 2 * I_QKV, T5 = T4 + 2 * I_WO, T6 = T5 + 2 * I_UQ, T7 = T6 + 2 * I_UKV;
        const bool bias_on = (rep_ == PROBE_CVT);
        auto desc = [&](int it) -> CvtD {
            CvtD d; d.kscale = nullptr; d.shiftp = nullptr; d.biasp = nullptr; d.bstride = 0;
            if (it < T0) { const int l = it / I_IN; d.item = it - l * I_IN; d.W = a.in[8] + (size_t)l * D * DFF; d.K = D; d.N = DFF; d.WT = (bf16*)(ws + WS_WIN) + (size_t)l * DFF * D;
                if (bias_on) { d.shiftp = MODp + (size_t)(2 * l + 1) * 4 * 6144; d.biasp = B7 + (size_t)l * 4 * 8192; d.bstride = 8192; } }
            else if (it < T1) { const int q = it - T0, l = q / I_OUT; d.item = q - l * I_OUT; d.W = a.in[9] + (size_t)l * DFF * D; d.K = DFF; d.N = D; d.WT = (bf16*)(ws + WS_WOUT) + (size_t)l * D * DFF; }
            else if (it < T2) { const int q = it - T1, l = q / I_EIN; d.item = q - l * I_EIN; d.W = a.in[10] + (size_t)l * D * EIN; d.K = D; d.N = EIN; d.WT = (bf16*)(ws + WS_WEIN) + (size_t)l * EINP * D;
                if (bias_on && l > 0) { d.shiftp = MODp + (size_t)(4 * l) * 4 * 6144; d.biasp = B1 + (size_t)(2 * l) * 4 * 4096; d.bstride = 4096; } }
            else if (it < T3) { const int q = it - T2, l = q / I_EOUT; d.item = q - l * I_EOUT; d.W = a.in[26] + (size_t)l * D * D; d.K = D; d.N = D; d.WT = (bf16*)(ws + WS_WEOUT) + (size_t)l * D * D; }
            else if (it < T4) { const int q = it - T3, l = q / I_QKV; d.item = q - l * I_QKV; d.W = a.in[27] + (size_t)l * D * NQKV; d.K = D; d.N = NQKV; d.WT = (bf16*)(ws + WS_WQKV) + (size_t)l * NQKV * D;
                if (bias_on) { d.shiftp = MODp + (size_t)(4 * l + 2) * 4 * 6144; d.biasp = B1 + (size_t)(2 * l + 1) * 4 * 4096; d.bstride = 4096; } }
            else if (it < T5) { const int q = it - T4, l = q / I_WO; d.item = q - l * I_WO; d.W = a.in[29] + (size_t)l * D * D; d.K = D; d.N = D; d.WT = (bf16*)(ws + WS_WO) + (size_t)l * D * D; }
            else if (it < T6) { const int q = it - T5, l = q / I_UQ; d.item = q - l * I_UQ; d.W = a.in[13] + (size_t)l * QL_W * NQ_MLA; d.K = QL_W; d.N = NQ_MLA; d.WT = (bf16*)(ws + WS_WUQ) + (size_t)l * NQ_MLA * QL_W; d.kscale = a.in[11] + l * QL_W; }
            else { const int q = it - T6, l = q / I_UKV; d.item = q - l * I_UKV; d.W = a.in[14] + (size_t)l * KVL_W * NKV_MLA; d.K = KVL_W; d.N = NKV_MLA; d.WT = (bf16*)(ws + WS_WUKV) + (size_t)l * NKV_MLA * KVL_W; d.kscale = a.in[12] + l * KVL_W; }
            return d; };
        int it = gw;
        if (it < T7) {
            CvtD d = desc(it); f32x4 v[16]; cvt_load(d, F.lane, v);
            for (;;) {
                const int itn = it + NGW; const bool hn = itn < T7; CvtD dn = d; f32x4 vn[16];
                if (hn) { dn = desc(itn); cvt_load(dn, F.lane, vn); }
                cvt_store(d, scr, F.lane, v);
                if (!hn) break;
                d = dn; it = itn;
#pragma unroll
                for (int i = 0; i < 16; ++i) v[i] = vn[i];
            }
        }
    }
}

__device__ __forceinline__ void p0_tables(Frame& F, const Args& a) {
    unsigned char* ws = F.ws;
    const int gw = F.vcu * NWAVES + F.wave, NGW = F.G * NWAVES;
    {
        const int gt = F.vcu * (NWAVES * 64) + F.tid, NT = F.G * NWAVES * 64;
        f32x2* r64 = (f32x2*)(ws + WS_ROPE64); f32x2* r32 = (f32x2*)(ws + WS_ROPE32); f32x2* tw = (f32x2*)(ws + WS_TW);
        for (int i = gt; i < 2048 * 32; i += NT) { const int pos = i >> 5, k = i & 31; const float inv = (float)exp(-(double)k / 32.0 * log(500000.0)); const float ang = (float)pos * inv;
            r64[i] = (f32x2){(float)cos((double)ang), (float)sin((double)ang)}; }
        for (int i = gt; i < 2048 * 16; i += NT) { const int pos = i >> 4, k = i & 15; const float inv = (float)exp(-(double)k / 16.0 * log(500000.0)); const float ang = (float)pos * inv;
            r32[i] = (f32x2){(float)cos((double)ang), (float)sin((double)ang)}; }
        for (int i = gt; i < hy::NTWC; i += NT) {
            int lh = 11; while (lh > 1 && i >= hy::twb(lh - 2)) lh -= 2;
            const int hq = 1 << (lh - 1), r = i - hy::twb(lh), second = r >= hq, pos = second ? r - hq : r, idx = second ? (pos << (12 - lh)) : (pos << (11 - lh));
            const double an = 2.0 * 3.14159265358979323846 * (double)idx / 4096.0; tw[i] = (f32x2){(float)cos(an), (float)(-sin(an))}; }
        float* w4t = (float*)(ws + WS_W4T);
        for (int i = gt; i < 2 * 4096 * 64; i += NT) { const int li = i / (4096 * 64), r = i - li * (4096 * 64), j = r >> 12, col = r & 4095;
            w4t[(size_t)li * 4096 * 64 + (size_t)col * 64 + j] = a.in[24][(size_t)li * 64 * 4096 + (size_t)j * 4096 + col]; }
    }
    {
        float* h3 = (float*)(ws + WS_H3);
        for (int t2 = gw; t2 < 2 * 2048; t2 += NGW) {
            const int li = t2 >> 11, t = t2 & 2047, n = F.lane;
            const float* w1 = a.in[17] + li * 33 * 64; const float* b1 = a.in[18] + li * 64; const float* w2 = a.in[19] + li * 64 * 64; const float* b2 = a.in[20] + li * 64;
            const float* w3 = a.in[21] + li * 64 * 64; const float* b3 = a.in[22] + li * 64; const float fr = a.in[23][li * 64 + n];
            const float tt = (float)t / 2047.0f; const float wpos = (6.283185307179586f * (float)t) / 2048.0f;
            float zf = tt;
            if (n >= 1 && n <= 32) { const int k = (n - 1) & 15; const float fb = 1e-4f + (float)k * ((15.0f - 1e-4f) / 15.0f); const float fwv = wpos * fb; zf = (n <= 16) ? cosf(fwv) : -sinf(fwv); }
            float acc = b1[n];
#pragma unroll
            for (int j = 0; j < 33; ++j) acc += __builtin_bit_cast(float, __builtin_amdgcn_readlane(__builtin_bit_cast(int, zf), j)) * w1[j * 64 + n];
            float h = sinf(fr * acc);
            acc = b2[n];
#pragma unroll 8
            for (int j = 0; j < 64; ++j) acc += __builtin_bit_cast(float, __builtin_amdgcn_readlane(__builtin_bit_cast(int, h), j)) * w2[j * 64 + n];
            h = sinf(fr * acc);
            acc = b3[n];
#pragma unroll 8
            for (int j = 0; j < 64; ++j) acc += __builtin_bit_cast(float, __builtin_amdgcn_readlane(__builtin_bit_cast(int, h), j)) * w3[j * 64 + n];
            h = sinf(fr * acc);
            h3[(size_t)t2 * 64 + n] = h;
        }
    }
}

__device__ __forceinline__ void kf_gen(Frame& F) {
    typedef float f32x16 __attribute__((ext_vector_type(16)));
    const int gw = F.vcu * NWAVES + F.wave, NGW = F.G * NWAVES;
    const float* h3 = (const float*)(F.ws + WS_H3); const float* w4t = (const float*)(F.ws + WS_W4T); float* KF = (float*)(F.ws + WS_KF);
    const int r32 = F.lane & 31, hi = F.lane >> 5;
    for (int task = gw; task < 2 * 128 * 8; task += NGW) {
        const int li = task >> 10, ct = (task >> 3) & 127, tg = task & 7;
        f32x4 wa[16];
        { const float* wrow = w4t + ((size_t)li * 4096 + ct * 32 + r32) * 64;
#pragma unroll
          for (int q = 0; q < 16; ++q) wa[q] = *(const GAS f32x4*)(wrow + 4 * q); }
        float nd[16];
#pragma unroll
        for (int r = 0; r < 16; ++r) { const int c = (ct * 32 + (r & 3) + 8 * (r >> 2) + 4 * hi) & 1023;
            const float mind = -3.0701134573253944f, maxd = -15.350567286626972f;
            nd[r] = -fabsf(mind + (float)c * ((maxd - mind) / 1023.0f)) * (1.0f / 2047.0f); }
        f32x4 hb[16];
        { const float* hrow = h3 + ((size_t)li * 2048 + (tg * 8) * 32 + r32) * 64;
#pragma unroll
          for (int q = 0; q < 16; ++q) hb[q] = *(const GAS f32x4*)(hrow + 4 * q); }
#pragma unroll 1
        for (int tt = 0; tt < 8; ++tt) {
            const int t0 = (tg * 8 + tt) * 32, t = t0 + r32;
            f32x16 acc = f32x16{};
#pragma unroll
            for (int q = 0; q < 16; ++q) {
                acc = __builtin_amdgcn_mfma_f32_32x32x2f32(hi ? wa[q][1] : wa[q][0], hi ? hb[q][1] : hb[q][0], acc, 0, 0, 0);
                acc = __builtin_amdgcn_mfma_f32_32x32x2f32(hi ? wa[q][3] : wa[q][2], hi ? hb[q][3] : hb[q][2], acc, 0, 0, 0);
            }
            if (tt < 7) { const float* hrow = h3 + ((size_t)li * 2048 + t + 32) * 64;
#pragma unroll
              for (int q = 0; q < 16; ++q) hb[q] = *(const GAS f32x4*)(hrow + 4 * q); }
            const float tf = (float)t;
#pragma unroll
            for (int r = 0; r < 16; ++r) { const int c = ct * 32 + (r & 3) + 8 * (r >> 2) + 4 * hi;
                KF[((size_t)li * 4096 + c) * 2048 + t] = acc[r] * __expf(tf * nd[r]); }
        }
    }
}

__device__ __forceinline__ void norm_phase(Frame& F, const float* X, const float* g, const float* mod, bf16* H) {
    const int gw = F.vcu * NWAVES + F.wave, NGW = F.G * NWAVES;
    for (int r0 = gw * 4; r0 < M; r0 += NGW * 4) {
        const int b = r0 >> 11; const float* mb = mod + (size_t)b * 6144;
        f32x4 gs[8], sh[8];
#pragma unroll
        for (int j = 0; j < 8; ++j) { const int c = 4 * F.lane + 256 * j; const f32x4 gg = *(const GAS f32x4*)(g + c), sc = *(const GAS f32x4*)(mb + 2048 + c); gs[j] = gg * (sc + 1.0f); sh[j] = *(const GAS f32x4*)(mb + c); }
#pragma unroll 1
        for (int rr = 0; rr < 4; ++rr) {
            const int row = r0 + rr; const float* xr = X + (size_t)row * D + 4 * F.lane;
            f32x4 v[8]; float s = 0.f;
#pragma unroll
            for (int j = 0; j < 8; ++j) { v[j] = *(const GAS f32x4*)(xr + 256 * j); s += (v[j].x * v[j].x + v[j].y * v[j].y) + (v[j].z * v[j].z + v[j].w * v[j].w); }
            const float rstd = 1.0f / sqrtf(wave_sum(s) * (1.0f / D) + RMS_EPS);
            bf16* hr = H + (size_t)row * D + 4 * F.lane;
#pragma unroll
            for (int j = 0; j < 8; ++j) { const f32x4 o = v[j] * rstd * gs[j] + sh[j]; v2u w; w.x = pk2(o.x, o.y); w.y = pk2(o.z, o.w); *(GAS v2u*)(hr + 256 * j) = w; }
        }
    }
}
__device__ __forceinline__ void final_norm_phase(Frame& F, float* X, const float* g) {
    const int gw = F.vcu * NWAVES + F.wave, NGW = F.G * NWAVES;
    f32x4 gs[8];
#pragma unroll
    for (int j = 0; j < 8; ++j) gs[j] = *(const GAS f32x4*)(g + 4 * F.lane + 256 * j);
    for (int row = gw; row < M; row += NGW) {
        float* xr = X + (size_t)row * D + 4 * F.lane;
        f32x4 v[8]; float s = 0.f;
#pragma unroll
        for (int j = 0; j < 8; ++j) { v[j] = *(const GAS f32x4*)(xr + 256 * j); s += (v[j].x * v[j].x + v[j].y * v[j].y) + (v[j].z * v[j].z + v[j].w * v[j].w); }
        const float rstd = 1.0f / sqrtf(wave_sum(s) * (1.0f / D) + RMS_EPS);
#pragma unroll
        for (int j = 0; j < 8; ++j) *(GAS f32x4*)(xr + 256 * j) = v[j] * rstd * gs[j];
    }
}

__device__ __forceinline__ void e3_phase(Frame& F, const bf16* Z, const float* cw  , const float* cb  ) {
    unsigned char* ws = F.ws;
    const int gw = F.vcu * NWAVES + F.wave, NGW = F.G * NWAVES;
    bf16* KR = (bf16*)(ws + WS_KR); const f32x2* r64 = (const f32x2*)(ws + WS_ROPE64);
    for (int rb = gw; rb < M; rb += 4 * NGW) {
        float kr4[4]; f32x2 cs4[4];
#pragma unroll
        for (int i = 0; i < 4; ++i) { const int row = rb + i * NGW; if (row < M) { kr4[i] = bflo((unsigned)Z[(size_t)row * EINP + 768 + F.lane]); cs4[i] = r64[(size_t)(row & 2047) * 32 + (F.lane & 31)]; } }
#pragma unroll
        for (int i = 0; i < 4; ++i) { const int row = rb + i * NGW; if (row < M) {
        const float kr = kr4[i];
        float other; { auto rr = __builtin_amdgcn_permlane32_swap(__float_as_uint(kr), __float_as_uint(kr), false, false); other = __uint_as_float(F.lane < 32 ? rr[1] : rr[0]); }
        const f32x2 cs = cs4[i];
        const float rot = F.lane < 32 ? kr * cs.x - other * cs.y : kr * cs.x + other * cs.y;
        KR[(size_t)row * 64 + F.lane] = (bf16)(pk2(rot, 0.f) & 0xffffu);
        } }
    }
    LAS unsigned* tile = (LAS unsigned*)(F.lds + F.wave * 10240);
    LAS float* wts = (LAS float*)(F.lds + F.wave * 10240 + 8960);
    bf16* UT = (bf16*)(ws + WS_UT);
    for (int item = gw; item < (M / 64) * 48; item += NGW) {
        const int tb = item / 48, cgp = item - tb * 48, tok0 = tb * 64, hc0 = cgp * 64, b = tok0 >> 11, s0 = tok0 & 2047;
#pragma unroll
        for (int i = 0; i < 9; ++i) { const int rl = 8 * i + (F.lane >> 3); if (rl < 66) { const int s = s0 - 1 + rl; v4u x = (v4u){0u, 0u, 0u, 0u};
                if (s >= 0 && s < 2048) x = *(const GAS v4u*)(Z + (size_t)(b * 2048 + s) * EINP + 832 + hc0 + 8 * (F.lane & 7));
                LAS unsigned* d = tile + rl * 33 + 4 * (F.lane & 7); d[0] = x.x; d[1] = x.y; d[2] = x.z; d[3] = x.w; } }
        LDS_WAIT(); asm volatile("" ::: "memory");
        const int part = hc0 >> 10, c0 = hc0 & 1023;
        bf16* up = UT + ((size_t)(part * 4 + b) * 1024 + c0) * 2048 + s0 + F.lane;
        if (F.lane < 32) { const int hcl = hc0 + 2 * F.lane;
            const f32x2 a0 = *(const GAS f32x2*)(cw + hcl), a1 = *(const GAS f32x2*)(cw + 3072 + hcl), a2 = *(const GAS f32x2*)(cw + 6144 + hcl), ab = *(const GAS f32x2*)(cb + hcl);
            *(LAS f32x4*)(wts + F.lane * 8) = (f32x4){a0.x, a1.x, a2.x, ab.x}; *(LAS f32x4*)(wts + F.lane * 8 + 4) = (f32x4){a0.y, a1.y, a2.y, ab.y}; }
        LDS_WAIT(); asm volatile("" ::: "memory");
#pragma unroll 8
        for (int cp = 0; cp < 32; ++cp) {
            const unsigned xm = tile[(F.lane) * 33 + cp], x0 = tile[(F.lane + 1) * 33 + cp], xp = tile[(F.lane + 2) * 33 + cp];
            const f32x4 wx = *(const LAS f32x4*)(wts + cp * 8), wy = *(const LAS f32x4*)(wts + cp * 8 + 4);
            const float y0 = wx[3] + wx[0] * bflo(xm) + wx[1] * bflo(x0) + wx[2] * bflo(xp);
            const float y1 = wy[3] + wy[0] * bfhi(xm) + wy[1] * bfhi(x0) + wy[2] * bfhi(xp);
            const unsigned pk = pk2(y0, y1);
            up[(size_t)(2 * cp) * 2048] = (bf16)(pk & 0xffffu); up[(size_t)(2 * cp + 1) * 2048] = (bf16)(pk >> 16);
        }
        LDS_WAIT(); asm volatile("" ::: "memory");
    }
}
__device__ __forceinline__ void o2b_phase(Frame& F, bf16* Z) {
    const int gw = F.vcu * NWAVES + F.wave, NGW = F.G * NWAVES; const f32x2* r32 = (const f32x2*)(F.ws + WS_ROPE32);
    for (int row = gw; row < M; row += NGW) {
        const int hd = F.lane >> 4, i = F.lane & 15; bf16* p = Z + (size_t)row * NQKV + 2048 + hd * 128 + i;
        const float x1 = bflo((unsigned)p[0]), x2 = bflo((unsigned)p[16]); const f32x2 cs = r32[(size_t)(row & 2047) * 16 + i];
        const unsigned pk = pk2(x1 * cs.x - x2 * cs.y, x2 * cs.x + x1 * cs.y);
        p[0] = (bf16)(pk & 0xffffu); p[16] = (bf16)(pk >> 16);
    }
}

constexpr int PH_FINAL = 42, PH_END = 43;
__global__ void __launch_bounds__(NWAVES * 64, 2) mk_fwd(Args args) {
    extern __shared__ __attribute__((aligned(16))) unsigned char lds[];
    Frame F;
    F.lds = (LAS unsigned char*)lds;
    F.MISC = (volatile LAS unsigned*)(F.lds + MISC_OFF);
    F.tid = threadIdx.x; F.lane = F.tid & 63; F.wave = __builtin_amdgcn_readfirstlane(F.tid >> 6);
    F.G = gridDim.x; { const int bx = blockIdx.x; F.vcu = (F.G % 8 == 0) ? (bx % 8) * (F.G / 8) + bx / 8 : bx; }
    F.ws = args.ws; F.ctl = (gu32*)(args.ws + WS_CTL);
    for (int u = F.tid; u < (LDS_BYTES - LDSCTL_OFF) / 4; u += NWAVES * 64) ((LAS unsigned*)(F.lds + LDSCTL_OFF))[u] = 0u;
    __syncthreads();
    XcdBarrier bar; bar.bar = (unsigned*)(F.ctl + CW_BAR); bar.x = 0; bar.st = nullptr;
    if (!MK_MULTI) bar = xcd_barrier_post((unsigned*)(F.ctl + CW_BAR), F.MISC + 8);
    const int lo = args.ph_lo, hi = args.ph_hi;
    unsigned char* ws = args.ws;
#define IN(k) (lo <= (k) && (k) < hi)
#if defined(SKIP_GEMM) || defined(SKIP_G1)
#define GEMM_CALL_G1 if (0)
#else
#define GEMM_CALL_G1
#endif
#if defined(SKIP_GEMM) || defined(SKIP_G3A)
#define GEMM_CALL_G3A if (0)
#else
#define GEMM_CALL_G3A
#endif
#if defined(SKIP_GEMM) || defined(SKIP_G3B)
#define GEMM_CALL_G3B if (0)
#else
#define GEMM_CALL_G3B
#endif
#if defined(SKIP_GEMM) || defined(SKIP_G5)
#define GEMM_CALL_G5 if (0)
#else
#define GEMM_CALL_G5
#endif
#if defined(SKIP_GEMM) || defined(SKIP_G7)
#define GEMM_CALL_G7 if (0)
#else
#define GEMM_CALL_G7
#endif
#if defined(SKIP_GEMM) || defined(SKIP_G8)
#define GEMM_CALL_G8 if (0)
#else
#define GEMM_CALL_G8
#endif
#define RELAUNDER() do { int w_ = F.wave, c_ = F.vcu, g_ = F.G; asm volatile("" : "+s"(w_), "+s"(c_), "+s"(g_)); F.wave = w_; F.vcu = c_; F.G = g_; { GAS unsigned char* q_ = (GAS unsigned char*)args.ws; asm volatile("" : "+s"(q_)); ws = (unsigned char*)q_; F.ws = ws; }     int l_; asm volatile("v_mbcnt_lo_u32_b32 %0, -1, 0\n\tv_mbcnt_hi_u32_b32 %0, -1, %0" : "=v"(l_)); F.lane = l_; F.tid = w_ * 64 + l_; } while (0)
#define SEAM() do { if (!MK_MULTI) { REP(BAR) xcd_barrier(bar, F.tid == 0); } } while (0)
    float* X = args.out;
#define H ((bf16*)(ws + WS_H))
#define Z ((bf16*)(ws + WS_Z))
#define MIX ((bf16*)(ws + WS_MIX))
#define HID ((bf16*)(ws + WS_HID))
#define MOD ((const float*)(ws + CTL_MOD_OFF))
#define ROWSS ((float*)(ws + CTL_ROWSS_OFF))
#define ROWSS2 ((float*)(ws + CTL_ROWSS2_OFF))
#define BIAS7 ((const float*)(ws + CTL_BIAS7_OFF))
#define BIAS1 ((const float*)(ws + CTL_BIAS1_OFF))

#ifndef SKIP_P0
    if (IN(0)) { RELAUNDER(); p0_ada(F, args); p0_tables(F, args); SEAM(); }
    if (IN(1)) { RELAUNDER(); p0_convert(F, args);
#ifndef SKIP_NORM
        REP(NORM) norm_phase(F, args.in[0], args.in[4], MOD, H);
#endif
#ifndef SKIP_KF
        REP(KF) kf_gen(F);
#endif
        SEAM(); }
#endif

#pragma unroll 1
    for (int l = 0; l < DEPTH; ++l) {
        const int base = 2 + 10 * l, i2 = l >> 1; const bool even = (l & 1) == 0;
        const float* xin = (l == 0) ? args.in[0] : X;
        if (IN(base + 1)) { RELAUNDER();
            const int N = even ? EINP : NQKV;
            const bf16* Wt = even ? (const bf16*)(ws + WS_WEIN) + (size_t)i2 * EINP * D : (const bf16*)(ws + WS_WQKV) + (size_t)i2 * NQKV * D;
            pg8::Gemm g{H, Wt, M, N, D}; pg8::StaticOrder S; S.init(M, N, F.G, (int)blockIdx.x);
            pg8::EpiBf16<0> E{Z, N, l > 0 ? ROWSS + (size_t)(2 * l) * M : nullptr, BIAS1 + (size_t)l * 4 * 4096, 4096, 1.0f / 2048.0f, even ? ROWSS2 + (size_t)(2 * i2) * M : nullptr, ROWSS2 + (size_t)(2 * i2 + 1) * M, even ? nullptr : (const float*)(ws + WS_ROPE32)};
            REP(G1) GEMM_CALL_G1 pg8::gemm_phase<pg8::EpiBf16<0>, pg8::StaticOrder, PG8_ALIGN, PG8_SP2>(F.lds, g, S, E, F.tid);
#ifndef SKIP_KH
            if (l == 1 && (int)blockIdx.x >= F.G / 2) {
                const int nh = F.G - F.G / 2;
                asm volatile("s_waitcnt vmcnt(0) lgkmcnt(0)\n\ts_barrier" ::: "memory");
                hy::load_tw(F.lds, (const hy::f32x2*)(ws + WS_TW), F.tid);
                HY_SYNC();
                for (int t = (int)blockIdx.x - F.G / 2; t < 512; t += nh) hy::khat_task(F.lds, (const float*)(ws + WS_KF), (hy::f32x2*)(ws + WS_KH), 1, t, F.tid);
            }
#endif
            SEAM();
        }
        if (even && IN(base + 2)) { RELAUNDER();
          REP(G3) {
            { pg8::Gemm g{Z, (const bf16*)(ws + WS_WUQ) + (size_t)i2 * NQ_MLA * QL_W, M, NQ_MLA, QL_W, EINP}; pg8::StaticOrder S; S.init(M, NQ_MLA, F.G, (int)blockIdx.x);
              pg8::EpiBf16<0> E{(bf16*)(ws + WS_Q), NQ_MLA, ROWSS2 + (size_t)(2 * i2) * M, nullptr, 0, 1.0f / 512.0f, nullptr, nullptr, nullptr};
              GEMM_CALL_G3A pg8::gemm_phase<pg8::EpiBf16<0>, pg8::StaticOrder, PG8_ALIGN, PG8_SP2>(F.lds, g, S, E, F.tid); }
            __syncthreads();
            { pg8::Gemm g{Z + 512, (const bf16*)(ws + WS_WUKV) + (size_t)i2 * NKV_MLA * KVL_W, M, NKV_MLA, KVL_W, EINP}; pg8::StaticOrder S; S.init(M, NKV_MLA, F.G, (int)blockIdx.x);
              pg8::EpiBf16<0> E{(bf16*)(ws + WS_KV), NKV_MLA, ROWSS2 + (size_t)(2 * i2 + 1) * M, nullptr, 0, 1.0f / 256.0f, nullptr, nullptr, nullptr};
              GEMM_CALL_G3B pg8::gemm_phase<pg8::EpiBf16<0>, pg8::StaticOrder, PG8_ALIGN, PG8_SP2>(F.lds, g, S, E, F.tid); }
            __syncthreads(); }
#ifndef SKIP_THIN
            REP(E3) e3_phase(F, Z, args.in[15] + (size_t)i2 * 3 * 3072, args.in[16] + (size_t)i2 * 3072);
#endif
#ifndef SKIP_KH
            if (l == 0) {
                asm volatile("s_waitcnt vmcnt(0) lgkmcnt(0)\n\ts_barrier" ::: "memory");
                hy::load_tw(F.lds, (const hy::f32x2*)(ws + WS_TW), F.tid);
                HY_SYNC();
                REP(KH) for (int t = F.vcu; t < 512; t += F.G) hy::khat_task(F.lds, (const float*)(ws + WS_KF), (hy::f32x2*)(ws + WS_KH), 0, t, F.tid);
            }
#endif
            SEAM();
        }
        if (IN(base + 4)) { RELAUNDER();
            if (even) {
                const bf16* Qb = (const bf16*)(ws + WS_Q); const bf16* KVb = (const bf16*)(ws + WS_KV); const bf16* KRb = (const bf16*)(ws + WS_KR);
                const float scale = 0.07216878364870322f;
#ifndef SKIP_MLA
                REP(MLA) for (int u = F.vcu; u < 256; u += F.G) {
                    const int b = u >> 6, h = (u >> 3) & 7, qb = u & 7; const size_t rb = (size_t)b * SEQ;
                    att::attn_unit<192, 0>(F.lds, Qb + rb * NQ_MLA + h * 192, NQ_MLA, KVb + rb * NKV_MLA + h * 256, NKV_MLA, KRb + rb * 64, KVb + rb * NKV_MLA + h * 256 + 128, NKV_MLA,
                                           MIX + rb * D + h * 128, (const att::f32x2*)(ws + WS_ROPE64), qb * 256, 0, 32, scale * 1.4426950408889634f, 8.0f / scale, nullptr, F.tid);
                }
#endif
#ifndef SKIP_HY
                asm volatile("s_waitcnt vmcnt(0) lgkmcnt(0)\n\ts_barrier" ::: "memory");
                hy::load_tw(F.lds, (const hy::f32x2*)(ws + WS_TW), F.tid);
                HY_SYNC();
                REP(HY) for (int u = F.vcu; u < 256; u += F.G)
                    hy::hyena_unit(F.lds, (const unsigned short*)(ws + WS_UT), (const hy::f32x2*)(ws + WS_KH) + (size_t)i2 * 2 * 1024 * 4096, args.in[25] + (size_t)i2 * 2 * 1024, MIX, 4 * u, F.tid);
#endif
            } else {
                const float scale = 0.08838834764831845f;
#ifndef SKIP_GQA
                REP(GQA) for (int u = F.vcu; u < 512; u += F.G) {
                    const int b = u >> 7, kvh = (u >> 5) & 3, qblk = u & 31; const size_t rb = (size_t)b * SEQ;
                    const int tlo = qblk - 2 < 0 ? 0 : qblk - 2, thi = qblk + 3 > 32 ? 32 : qblk + 3;
                    att::attn_unit<128, 1>(F.lds, Z + rb * NQKV + kvh * 512, NQKV, Z + rb * NQKV + 2048 + kvh * 128, NQKV, nullptr, Z + rb * NQKV + 2560 + kvh * 128, NQKV,
                                           MIX + rb * D + kvh * 512, (const att::f32x2*)(ws + WS_ROPE32), qblk * 64, tlo, thi, scale * 1.4426950408889634f, 8.0f / scale,
                                           args.in[28] + i2 * 16 + kvh * 4, F.tid);
                }
#endif
            }
            SEAM();
        }
        if (IN(base + 5)) { RELAUNDER();
            const bf16* Wt = even ? (const bf16*)(ws + WS_WEOUT) + (size_t)i2 * D * D : (const bf16*)(ws + WS_WO) + (size_t)i2 * D * D;
            pg8::Gemm g{MIX, Wt, M, D, D}; pg8::StaticOrder S; S.init(M, D, F.G, (int)blockIdx.x);
            REP(G5) { pg8::EpiResGate E{xin, rep_ == PROBE_G5 ? X : (float*)(ws + WS_END), MOD + (size_t)(2 * l) * 4 * 6144 + 4096,
                rep_ == PROBE_G5 ? H : nullptr, args.in[7] + l * D, MOD + (size_t)(2 * l + 1) * 4 * 6144 + 2048, ROWSS + (size_t)(2 * l + 1) * M};
            GEMM_CALL_G5 pg8::gemm_phase<pg8::EpiResGate, pg8::StaticOrder, PG8_ALIGN, PG8_SP2>(F.lds, g, S, E, F.tid); }
            SEAM();
        }
        if (IN(base + 7)) { RELAUNDER();
            pg8::Gemm g{H, (const bf16*)(ws + WS_WIN) + (size_t)l * DFF * D, M, DFF, D}; pg8::StaticOrder S; S.init(M, DFF, F.G, (int)blockIdx.x);
            pg8::EpiBf16<2> E{HID, DFF, ROWSS + (size_t)(2 * l + 1) * M, BIAS7 + (size_t)l * 4 * 8192, 8192, 1.0f / 2048.0f, nullptr, nullptr, nullptr};
            REP(G7) GEMM_CALL_G7 pg8::gemm_phase<pg8::EpiBf16<2>, pg8::StaticOrder, PG8_ALIGN, PG8_SP2>(F.lds, g, S, E, F.tid);
#if PROBE_GK
            { pg8::Gemm g2{H, (const bf16*)(ws + WS_WIN) + (size_t)l * DFF * D, M, DFF, PROBE_GK};
              pg8::EpiBf16<2> E2{(bf16*)(ws + WS_END), DFF, ROWSS + (size_t)(2 * l + 1) * M, BIAS7 + (size_t)l * 4 * 8192, 8192, 1.0f / 2048.0f, nullptr, nullptr, nullptr};
              pg8::gemm_phase<pg8::EpiBf16<2>, pg8::StaticOrder, PG8_ALIGN, PG8_SP2>(F.lds, g2, S, E2, F.tid); }
#endif
            SEAM();
        }
        if (IN(base + 8)) { RELAUNDER();
            pg8::Gemm g{HID, (const bf16*)(ws + WS_WOUT) + (size_t)l * D * DFF, M, D, DFF}; pg8::StaticOrder S; S.init(M, D, F.G, (int)blockIdx.x);
            REP(G8) { pg8::EpiResGate E{X, rep_ == PROBE_G8 ? X : (float*)(ws + WS_END), MOD + (size_t)(2 * l + 1) * 4 * 6144 + 4096,
                (l < DEPTH - 1) ? (rep_ == PROBE_G8 ? H : (bf16*)(ws + WS_END + 64 * MiB)) : nullptr, args.in[4] + (l + 1 < DEPTH ? l + 1 : l) * D, MOD + (size_t)(2 * l + 2 < 8 ? 2 * l + 2 : 0) * 4 * 6144 + 2048, rep_ == PROBE_G8 ? ROWSS + (size_t)(2 * l + 2 < 8 ? 2 * l + 2 : 0) * M : (float*)(ws + WS_END + 96 * MiB)};
            GEMM_CALL_G8 pg8::gemm_phase<pg8::EpiResGate, pg8::StaticOrder, PG8_ALIGN, PG8_SP2>(F.lds, g, S, E, F.tid); }
            SEAM();
        }
    }
    if (IN(PH_FINAL)) { RELAUNDER(); final_norm_phase(F, X, args.in[30]); }
#undef IN
#undef SEAM
#undef H
#undef Z
#undef MIX
#undef HID
#undef MOD
#undef ROWSS
#undef ROWSS2
#undef BIAS7
#undef BIAS1
}

extern "C" void kernel_launch(void* const* d_in, const int* in_sizes, int n_in, void* d_out, int out_size, void* d_ws, size_t ws_size, hipStream_t stream) {
    static int grid = 0;
    if (grid == 0) {
        if (n_in != 31 || in_sizes[0] != M * D || out_size != M * D || ws_size < WS_END) {
            fprintf(stderr, "kernel_launch: shape mismatch (n_in %d, in0 %d, out %d, ws %zu, need %zu); nothing launched\n", n_in, n_in > 0 ? in_sizes[0] : -1, out_size, ws_size, (size_t)WS_END); grid = -1; return; }
        int dev = 0, cus = 0, per_cu = 0;
        if (hipGetDevice(&dev) != hipSuccess || hipDeviceGetAttribute(&cus, hipDeviceAttributeMultiprocessorCount, dev) != hipSuccess) { fprintf(stderr, "kernel_launch: device query failed\n"); grid = -1; return; }
        if (hipFuncSetAttribute((const void*)mk_fwd, hipFuncAttributeMaxDynamicSharedMemorySize, LDS_BYTES) != hipSuccess) { fprintf(stderr, "kernel_launch: hipFuncSetAttribute failed\n"); grid = -1; return; }
        if (hipOccupancyMaxActiveBlocksPerMultiprocessor(&per_cu, (const void*)mk_fwd, NWAVES * 64, LDS_BYTES) != hipSuccess || per_cu < 1)
            fprintf(stderr, "kernel_launch: note: occupancy query reports %d workgroups per CU\n", per_cu);
        (void)hipGetLastError();
        grid = cus;
    }
    if (grid < 0) return;
    if (hipMemsetAsync((char*)d_ws + WS_CTL, 0, CTL_ZERO_BYTES, stream) != hipSuccess) { fprintf(stderr, "kernel_launch: memset failed\n"); return; }
    Args a{};
    for (int i = 0; i < 31; ++i) a.in[i] = (const float*)d_in[i];
    a.out = (float*)d_out; a.ws = (unsigned char*)d_ws;
#if MK_MULTI
    for (int p = 0; p < PH_END; ++p) {
        if (p >= 2 && p <= 41) { const int k = (p - 2) % 10, l = (p - 2) / 10; if (k == 9 || k == 6 || k == 0 || k == 3 || (k == 2 && (l & 1))) continue; }
        a.ph_lo = p; a.ph_hi = p + 1;
        hipLaunchKernelGGL(mk_fwd, dim3(grid), dim3(NWAVES * 64), LDS_BYTES, stream, a);
    }
#else
    a.ph_lo = 0; a.ph_hi = PH_END;
    hipLaunchKernelGGL(mk_fwd, dim3(grid), dim3(NWAVES * 64), LDS_BYTES, stream, a);
#endif
    const hipError_t le = hipPeekAtLastError();
    if (le != hipSuccess) fprintf(stderr, "kernel_launch: launch failed: %s (grid %d)\n", hipGetErrorName(le), grid);
}
```

```cpp
#include <hip/hip_runtime.h>
#include <cstdio>
#include <cstdint>
#include <cmath>
namespace pg8 {
#define PG8_LAS __attribute__((address_space(3)))
typedef unsigned short bf16_t;
typedef short bf16x8 __attribute__((ext_vector_type(8)));
typedef float f32x4 __attribute__((ext_vector_type(4)));
typedef unsigned u32x4 __attribute__((ext_vector_type(4)));
constexpr int BM = 256, BK = 64, HALF = 128, HTB = HALF * BK * 2  , STAGE_BYTES = 8 * HTB, NXCD = 8, WGM = 4;

__host__ __device__ __forceinline__ int lds_byte(int r, int c) { const int st = (r >> 4) * 2 + (c >> 5), rr = r & 15, cc = c & 31, ob = rr * 64 + cc * 2; return st * 1024 + (ob ^ (((ob >> 9) & 1) << 5)); }
__host__ __device__ __forceinline__ void stage_rc(int b, int& R, int& C) { const int st = b / 1024, sb = b % 1024, swz = sb ^ (((sb >> 9) & 1) << 5); R = (st >> 1) * 16 + swz / 64; C = (st & 1) * 32 + (swz % 64) / 2; }
__host__ __device__ __forceinline__ int perm32(int rho) { const int n = rho >> 4, i = rho & 15; return 8 * (i >> 2) + 4 * n + (i & 3); }

struct Unit { int pm, pn; };
struct Gemm { const bf16_t* A; const bf16_t* Bt; int M, N, K, lda; };

struct StaticOrder {
    int nM, nN, nwg, G, c;
    __host__ __device__ void init(int M, int N, int G_, int c_) { nM = M / BM; nN = N / BM; nwg = nM * nN; G = G_; c = c_; }
    __host__ __device__ bool next(int i, Unit& u) const {
        const long L = (long)i * G + c; if (L >= nwg) return false;
        int wgid = (int)L; { const int q = nwg / NXCD, r = nwg % NXCD, xcd = wgid % NXCD, off = wgid / NXCD; wgid = (xcd < r ? xcd * (q + 1) : r * (q + 1) + (xcd - r) * q) + off; }
        const int nig = WGM * nN, gid = wgid / nig, fm = gid * WGM, gsz = (nM - fm) < WGM ? (nM - fm) : WGM;
        u.pm = fm + ((wgid % nig) % gsz); u.pn = (wgid % nig) / gsz; return true;
    }
    __device__ __forceinline__ void a_ready(const Unit&) const {}
    __device__ __forceinline__ void done(const Unit&) const {}
};

typedef unsigned u32x2 __attribute__((ext_vector_type(2)));
__device__ __forceinline__ unsigned cvt_pk_bf16(float lo, float hi) { unsigned r; asm volatile("v_cvt_pk_bf16_f32 %0, %1, %2" : "=v"(r) : "v"(lo), "v"(hi)); return r; }

template <int ACT> struct EpiBf16 {
    static constexpr bool PERM = true, AFTER_DRAIN = false;
    bf16_t* O; int ldc; const float* rowss; const float* bias; int bstride;
    float inv_n;
    float* sq0; float* sq1;
    const float* rope;
    __device__ __forceinline__ void operator()(const f32x4 (&acc)[2][2][4][2], const Unit& u, int wr, int wc, int fr, int fq) const {
        const int row0 = u.pm * BM + wr * 64 + fr; const int col0 = u.pn * BM + wc * 32 + 8 * fq;
        f32x4 bv[2][2];
        if (rowss) { const float* bp = bias + (size_t)(u.pm >> 3) * bstride + col0;
#pragma unroll
            for (int bj = 0; bj < 2; ++bj) { bv[bj][0] = bias ? *(const f32x4*)(bp + bj * HALF) : (f32x4){0.f, 0.f, 0.f, 0.f}; bv[bj][1] = bias ? *(const f32x4*)(bp + bj * HALF + 4) : (f32x4){0.f, 0.f, 0.f, 0.f}; } }
        float* sqp = nullptr; if (sq0) { if (u.pn < 2) sqp = sq0; else if (u.pn == 2) sqp = sq1; }
        float rr[2][4];
#pragma unroll
        for (int ai = 0; ai < 2; ++ai)
#pragma unroll
            for (int m = 0; m < 4; ++m) rr[ai][m] = rowss ? rowss[row0 + ai * HALF + m * 16] : 1.0f;
#pragma unroll
        for (int ai = 0; ai < 2; ++ai)
#pragma unroll
            for (int m = 0; m < 4; ++m) { float t = __builtin_amdgcn_rsqf(rr[ai][m] * inv_n + 1e-6f); asm volatile("" : "+v"(t)); rr[ai][m] = rowss ? t : 1.0f; }
#pragma unroll
        for (int ai = 0; ai < 2; ++ai)
#pragma unroll
            for (int m = 0; m < 4; ++m) { const int row = row0 + ai * HALF + m * 16; bf16_t* rowp = O + (size_t)row * ldc + col0;
                const float r = rr[ai][m]; float ssq = 0.f;
#pragma unroll
                for (int bj = 0; bj < 2; ++bj) { f32x4 v0 = acc[ai][bj][m][0], v1 = acc[ai][bj][m][1];
                    if (rowss) { v0 = v0 * r + bv[bj][0]; v1 = v1 * r + bv[bj][1]; }
                    if (sqp) ssq += (v0[0] * v0[0] + v0[1] * v0[1]) + (v0[2] * v0[2] + v0[3] * v0[3]) + (v1[0] * v1[0] + v1[1] * v1[1]) + (v1[2] * v1[2] + v1[3] * v1[3]);
                    if (rope && wc == 0 && (u.pn == 8 || u.pn == 9)) {
                        const float* tb = rope + ((size_t)(row & 2047) * 16 + 8 * (fq & 1)) * 2;
                        const f32x4 t0 = *(const f32x4*)(tb), t1 = *(const f32x4*)(tb + 4), t2 = *(const f32x4*)(tb + 8), t3 = *(const f32x4*)(tb + 12);
                        const float cs[8] = {t0[0], t0[2], t1[0], t1[2], t2[0], t2[2], t3[0], t3[2]}, sn[8] = {t0[1], t0[3], t1[1], t1[3], t2[1], t2[3], t3[1], t3[3]};
                        const float sgn = fq < 2 ? -1.0f : 1.0f;
#pragma unroll
                        for (int e = 0; e < 4; ++e) {
                            { auto pr = __builtin_amdgcn_permlane32_swap(__float_as_uint(v0[e]), __float_as_uint(v0[e]), false, false); const float other = __uint_as_float(fq < 2 ? pr[1] : pr[0]); v0[e] = v0[e] * cs[e] + sgn * other * sn[e]; }
                            { auto pr = __builtin_amdgcn_permlane32_swap(__float_as_uint(v1[e]), __float_as_uint(v1[e]), false, false); const float other = __uint_as_float(fq < 2 ? pr[1] : pr[0]); v1[e] = v1[e] * cs[4 + e] + sgn * other * sn[4 + e]; }
                        }
                    }
                    if (ACT == 2) { f32x4 a, b;
#pragma unroll
                        for (int e = 0; e < 4; ++e) { a[e] = fmaxf(v0[e], 0.f); b[e] = fmaxf(v1[e], 0.f); }
                        v0 = a * a; v1 = b * b; }
                    u32x4 w; w.x = cvt_pk_bf16(v0[0], v0[1]); w.y = cvt_pk_bf16(v0[2], v0[3]); w.z = cvt_pk_bf16(v1[0], v1[1]); w.w = cvt_pk_bf16(v1[2], v1[3]);
                    *(u32x4*)(rowp + bj * HALF) = w; }
                if (sqp) { ssq += __builtin_bit_cast(float, __builtin_amdgcn_ds_swizzle(__builtin_bit_cast(int, ssq), 0x401F));
                    { auto pr = __builtin_amdgcn_permlane32_swap(__float_as_uint(ssq), __float_as_uint(ssq), false, false); ssq = __uint_as_float(pr[0]) + __uint_as_float(pr[1]); }
                    if (fq == 0) __hip_atomic_fetch_add(sqp + row, ssq, __ATOMIC_RELAXED, __HIP_MEMORY_SCOPE_AGENT); } }
    }
};
struct EpiResGate {
    static constexpr bool PERM = true, AFTER_DRAIN = false;
    const float* xin; float* xout; const float* gate;
    bf16_t* Hn; const float* ng; const float* nscale; float* nrowss;
    __device__ __forceinline__ void operator()(const f32x4 (&acc)[2][2][4][2], const Unit& u, int wr, int wc, int fr, int fq) const {
        const int b = u.pm >> 3; const float* g = gate + (size_t)b * 6144;
        const int col0 = u.pn * BM + wc * 32 + 8 * fq;
        f32x4 gv[2][2], gs[2][2];
#pragma unroll
        for (int bj = 0; bj < 2; ++bj)
#pragma unroll
            for (int n = 0; n < 2; ++n) { gv[bj][n] = *(const f32x4*)(g + col0 + bj * HALF + n * 4);
                if (Hn) gs[bj][n] = *(const f32x4*)(ng + col0 + bj * HALF + n * 4) * (*(const f32x4*)(nscale + (size_t)b * 6144 + col0 + bj * HALF + n * 4) + 1.0f); }
#pragma unroll
        for (int ai = 0; ai < 2; ++ai)
#pragma unroll
          for (int mp = 0; mp < 2; ++mp) {
            f32x4 xs[2][2][2];
#pragma unroll
            for (int mm = 0; mm < 2; ++mm) { const size_t off = (size_t)(u.pm * BM + ai * HALF + wr * 64 + (2 * mp + mm) * 16 + fr) * 2048 + col0;
#pragma unroll
                for (int bj = 0; bj < 2; ++bj)
#pragma unroll
                    for (int n = 0; n < 2; ++n) xs[mm][bj][n] = *(const f32x4*)(xin + off + bj * HALF + n * 4); }
            asm volatile("" ::: "memory");
#pragma unroll
            for (int mm = 0; mm < 2; ++mm) { const int m = 2 * mp + mm; const int row = u.pm * BM + ai * HALF + wr * 64 + m * 16 + fr; const size_t off = (size_t)row * 2048 + col0; float ss = 0.f;
#pragma unroll
                for (int bj = 0; bj < 2; ++bj) { f32x4 xo[2];
#pragma unroll
                    for (int n = 0; n < 2; ++n) { xo[n] = xs[mm][bj][n] + gv[bj][n] * acc[ai][bj][m][n];
                        *(f32x4*)(xout + off + bj * HALF + n * 4) = xo[n]; }
                    if (Hn) { ss += (xo[0][0] * xo[0][0] + xo[0][1] * xo[0][1]) + (xo[0][2] * xo[0][2] + xo[0][3] * xo[0][3]) + (xo[1][0] * xo[1][0] + xo[1][1] * xo[1][1]) + (xo[1][2] * xo[1][2] + xo[1][3] * xo[1][3]);
                        const f32x4 h0 = xo[0] * gs[bj][0], h1 = xo[1] * gs[bj][1];
                        u32x4 w; w.x = cvt_pk_bf16(h0[0], h0[1]); w.y = cvt_pk_bf16(h0[2], h0[3]); w.z = cvt_pk_bf16(h1[0], h1[1]); w.w = cvt_pk_bf16(h1[2], h1[3]);
                        *(u32x4*)(Hn + off + bj * HALF) = w; } }
                if (Hn) { ss += __builtin_bit_cast(float, __builtin_amdgcn_ds_swizzle(__builtin_bit_cast(int, ss), 0x401F));
                    { auto rr = __builtin_amdgcn_permlane32_swap(__float_as_uint(ss), __float_as_uint(ss), false, false); ss = __uint_as_float(rr[0]) + __uint_as_float(rr[1]); }
                    if (fq == 0) __hip_atomic_fetch_add(nrowss + row, ss, __ATOMIC_RELAXED, __HIP_MEMORY_SCOPE_AGENT); } }
            asm volatile("" ::: "memory");
          }
    }
};

template <class Epi, class Sched, bool ALIGN_EPI = false, bool SP2 = false>
__device__ __forceinline__ void gemm_phase(PG8_LAS unsigned char* lds, const Gemm g, const Sched& S, const Epi& E, int tid_in) {
    int tid_ = tid_in; asm volatile("" : "+v"(tid_));
    const int tid = tid_, wid = __builtin_amdgcn_readfirstlane(tid >> 6), lane = tid & 63, wr = wid >> 2, wc = wid & 3, fr = lane & 15, fq = lane >> 4;
    int K_ = g.K; asm volatile("" : "+s"(K_));
    const int K = K_, nt = K / BK; int lda_ = g.lda ? g.lda : K_; asm volatile("" : "+s"(lda_)); const int lda = lda_;
    unsigned voffA[2], voffB[2];
#pragma unroll
    for (int i = 0; i < 2; ++i) { int R, C; stage_rc(tid * 16 + i * 8192, R, C); const int Rb = Epi::PERM ? ((R & ~31) + perm32(R & 31)) : R;
        voffA[i] = (unsigned)(R * lda + C) * 2u; voffB[i] = (unsigned)(Rb * K + C) * 2u; }
    const size_t kstep = (size_t)(BK * 2);
    const size_t hstep = (size_t)HALF * K * 2;
    const size_t tstep = 2 * hstep; const size_t hstepA = (size_t)HALF * lda * 2, tstepA = 2 * hstepA;
    const unsigned ldsw = (unsigned)wid * 1024u;
    const int aoff = lds_byte(wr * 64 + fr, fq * 8), boff = lds_byte(wc * 32 + fr, fq * 8);
#define PG8_SA(b, h) (((b) * 2 + (h)) * HTB)
#define PG8_SB(b, h) ((4 + (b) * 2 + (h)) * HTB)
#define PG8_STAGE(bufoff, gbase, voff) do { _Pragma("unroll") for (int _i = 0; _i < 2; ++_i) \
        __builtin_amdgcn_global_load_lds((const unsigned*)((const char*)(gbase) + (voff)[_i]), (PG8_LAS unsigned*)(lds + (bufoff) + ldsw + _i * 8192), 16, 0, 0); } while (0)
#define PG8_LDA(dst, b, h) do { _Pragma("unroll") for (int m = 0; m < 4; ++m) _Pragma("unroll") for (int k = 0; k < 2; ++k) dst[m][k] = *(const PG8_LAS bf16x8*)(lds + PG8_SA(b, h) + aoff + m * 2048 + k * 1024); } while (0)
#define PG8_LDB(dst, b, h) do { _Pragma("unroll") for (int n = 0; n < 2; ++n) _Pragma("unroll") for (int k = 0; k < 2; ++k) dst[n][k] = *(const PG8_LAS bf16x8*)(lds + PG8_SB(b, h) + boff + n * 2048 + k * 1024); } while (0)
#define PG8_MMA(ai, bj, At, Bt) do { __builtin_amdgcn_s_setprio(1); _Pragma("unroll") for (int m = 0; m < 4; ++m) _Pragma("unroll") for (int n = 0; n < 2; ++n) _Pragma("unroll") for (int k = 0; k < 2; ++k) \
        acc[ai][bj][m][n] = __builtin_amdgcn_mfma_f32_16x16x32_bf16(Bt[n][k], At[m][k], acc[ai][bj][m][n], 0, 0, 0); __builtin_amdgcn_s_setprio(0); } while (0)
#define PG8_WAIT_V(n) asm volatile("s_waitcnt vmcnt(" #n ")" ::: "memory")
#define PG8_WAIT_L(n) asm volatile("s_waitcnt lgkmcnt(" #n ")" ::: "memory")
#define PG8_BAR __builtin_amdgcn_s_barrier()
#define PG8_SCHED __builtin_amdgcn_sched_barrier(0)
    Unit cur, nxt; int ui = 0;
    if (!S.next(0, cur)) return;
    f32x4 acc[2][2][4][2];
#pragma unroll
    for (int a = 0; a < 2; ++a)
#pragma unroll
        for (int b = 0; b < 2; ++b)
#pragma unroll
            for (int m = 0; m < 4; ++m)
#pragma unroll
                for (int n = 0; n < 2; ++n) acc[a][b][m][n] = (f32x4){0.f, 0.f, 0.f, 0.f};
    bf16x8 At[4][2], B0[2][2], B1[2][2];
    const char* cA = (const char*)g.A + (size_t)cur.pm * tstepA; const char* cB = (const char*)g.Bt + (size_t)cur.pn * tstep;
    S.a_ready(cur);
    if constexpr (SP2) {
        PG8_STAGE(PG8_SB(0, 0), cB, voffB); PG8_STAGE(PG8_SB(0, 1), cB + hstep, voffB); PG8_STAGE(PG8_SA(0, 0), cA, voffA); PG8_STAGE(PG8_SA(0, 1), cA + hstepA, voffA);
        if (wr == 1) PG8_BAR;
        PG8_WAIT_V(2); PG8_BAR;
        PG8_STAGE(PG8_SB(1, 0), cB + kstep, voffB); PG8_STAGE(PG8_SA(1, 0), cA + kstep, voffA); PG8_STAGE(PG8_SB(1, 1), cB + hstep + kstep, voffB);
        PG8_WAIT_V(6); PG8_BAR;
    } else {
        PG8_STAGE(PG8_SB(0, 0), cB, voffB); PG8_STAGE(PG8_SA(0, 0), cA, voffA); PG8_STAGE(PG8_SB(0, 1), cB + hstep, voffB); PG8_STAGE(PG8_SA(0, 1), cA + hstepA, voffA);
        if (wr == 1) PG8_BAR;
        PG8_WAIT_V(4); PG8_BAR;
        PG8_STAGE(PG8_SB(1, 0), cB + kstep, voffB); PG8_STAGE(PG8_SA(1, 0), cA + kstep, voffA); PG8_STAGE(PG8_SB(1, 1), cB + hstep + kstep, voffB);
        PG8_WAIT_V(6); PG8_BAR;
    }
    for (;;) {
        const bool has_next = S.next(ui + 1, nxt);
        const char* nA = has_next ? (const char*)g.A + (size_t)nxt.pm * tstepA : cA; const char* nB = has_next ? (const char*)g.Bt + (size_t)nxt.pn * tstep : cB;
        for (int t = 0; t < nt; t += 2) {
            const bool last = (t == nt - 2);
            const char* a1 = cA + (size_t)(t + 1) * kstep;
            const char* a2 = last ? nA : cA + (size_t)(t + 2) * kstep; const char* b2 = last ? nB : cB + (size_t)(t + 2) * kstep;
            const char* a3 = a2 + kstep; const char* b3 = b2 + kstep;
            if (last && has_next) S.a_ready(nxt);
            if constexpr (SP2) {
            PG8_LDB(B0, 0, 0); PG8_LDB(B1, 0, 1); PG8_SCHED; PG8_LDA(At, 0, 0); PG8_STAGE(PG8_SA(1, 1), a1 + hstepA, voffA);
            PG8_WAIT_V(8); PG8_WAIT_L(0); PG8_BAR; PG8_MMA(0, 0, At, B0); PG8_MMA(0, 1, At, B1); PG8_BAR; PG8_SCHED;
            PG8_LDA(At, 0, 1); PG8_STAGE(PG8_SB(0, 0), b2, voffB); PG8_STAGE(PG8_SB(0, 1), b2 + hstep, voffB); PG8_STAGE(PG8_SA(0, 0), a2, voffA);
            PG8_WAIT_V(8); PG8_WAIT_L(0); PG8_BAR; PG8_MMA(1, 0, At, B0); PG8_MMA(1, 1, At, B1); PG8_BAR; PG8_SCHED;
            PG8_LDB(B0, 1, 0); PG8_LDB(B1, 1, 1); PG8_SCHED; PG8_LDA(At, 1, 0); PG8_STAGE(PG8_SA(0, 1), a2 + hstepA, voffA);
            PG8_WAIT_V(8); PG8_WAIT_L(0); PG8_BAR; PG8_MMA(0, 0, At, B0); PG8_MMA(0, 1, At, B1); PG8_BAR; PG8_SCHED;
            PG8_LDA(At, 1, 1); PG8_STAGE(PG8_SB(1, 0), b3, voffB); PG8_STAGE(PG8_SB(1, 1), b3 + hstep, voffB); PG8_STAGE(PG8_SA(1, 0), a3, voffA);
            PG8_WAIT_V(8); PG8_WAIT_L(0); PG8_BAR; PG8_MMA(1, 0, At, B0); PG8_MMA(1, 1, At, B1); PG8_BAR; PG8_SCHED;
            } else {
            PG8_LDB(B0, 0, 0); PG8_SCHED; PG8_LDA(At, 0, 0); PG8_STAGE(PG8_SA(1, 1), a1 + hstepA, voffA);
            PG8_WAIT_L(8); PG8_BAR; PG8_WAIT_L(0); PG8_MMA(0, 0, At, B0); PG8_BAR; PG8_SCHED;
            PG8_LDB(B1, 0, 1); PG8_STAGE(PG8_SB(0, 0), b2, voffB);
            PG8_BAR; PG8_WAIT_L(0); PG8_MMA(0, 1, At, B1); PG8_BAR;
            PG8_LDA(At, 0, 1); PG8_STAGE(PG8_SA(0, 0), a2, voffA);
            PG8_BAR; PG8_WAIT_L(0); PG8_MMA(1, 0, At, B0); PG8_BAR; PG8_SCHED;
            PG8_STAGE(PG8_SB(0, 1), b2 + hstep, voffB);
            PG8_WAIT_V(6); PG8_BAR; PG8_MMA(1, 1, At, B1); PG8_BAR;
            PG8_LDB(B0, 1, 0); PG8_SCHED; PG8_LDA(At, 1, 0); PG8_STAGE(PG8_SA(0, 1), a2 + hstepA, voffA);
            PG8_WAIT_L(8); PG8_BAR; PG8_WAIT_L(0); PG8_MMA(0, 0, At, B0); PG8_BAR; PG8_SCHED;
            PG8_LDB(B1, 1, 1); PG8_STAGE(PG8_SB(1, 0), b3, voffB);
            PG8_BAR; PG8_WAIT_L(0); PG8_MMA(0, 1, At, B1); PG8_BAR;
            PG8_LDA(At, 1, 1); PG8_STAGE(PG8_SA(1, 0), a3, voffA);
            PG8_BAR; PG8_WAIT_L(0); PG8_MMA(1, 0, At, B0); PG8_BAR; PG8_SCHED;
            PG8_STAGE(PG8_SB(1, 1), b3 + hstep, voffB);
            PG8_WAIT_V(6); PG8_BAR; PG8_MMA(1, 1, At, B1); PG8_BAR;
            }
        }
        if constexpr (ALIGN_EPI) { if (wr == 0) PG8_BAR; }
        if constexpr (!Epi::AFTER_DRAIN) { E(acc, cur, wr, wc, fr, fq); S.done(cur); }
        if (!has_next) break;
#pragma unroll
        for (int a = 0; a < 2; ++a)
#pragma unroll
            for (int b = 0; b < 2; ++b)
#pragma unroll
                for (int m = 0; m < 4; ++m)
#pragma unroll
                    for (int n = 0; n < 2; ++n) acc[a][b][m][n] = (f32x4){0.f, 0.f, 0.f, 0.f};
        cur = nxt; cA = nA; cB = nB; ++ui;
        if constexpr (ALIGN_EPI) { if (wr == 1) PG8_BAR; }
    }
    PG8_WAIT_V(0);
    if constexpr (!ALIGN_EPI) { if (wr == 0) PG8_BAR; }
    PG8_BAR;
    if constexpr (Epi::AFTER_DRAIN) { E.fused(acc, cur, wr, wc, fr, fq, lds, wid, lane); S.done(cur); }
#undef PG8_SA
#undef PG8_SB
#undef PG8_STAGE
#undef PG8_LDA
#undef PG8_LDB
#undef PG8_MMA
#undef PG8_WAIT_V
#undef PG8_WAIT_L
#undef PG8_BAR
#undef PG8_SCHED
}
}

namespace att {
#define ATT_LAS __attribute__((address_space(3)))
typedef unsigned short bf16_t;
typedef short bf16x8 __attribute__((ext_vector_type(8)));
typedef short s16x4 __attribute__((ext_vector_type(4)));
typedef float f32x16 __attribute__((ext_vector_type(16)));
typedef unsigned u32x4 __attribute__((ext_vector_type(4)));
typedef float f32x2 __attribute__((ext_vector_type(2)));
constexpr int SLOT = 40960, OFF_KN = 0, OFF_V = 16384, OFF_KR = 32768, NSLOT = 3, OFF_SCR = NSLOT * SLOT, LDS_BYTES = OFF_SCR + 8 * 256;
#define ATT_SBAR() __builtin_amdgcn_sched_barrier(0)
__device__ __forceinline__ int crow(int r, int hi) { return (r & 3) + 8 * (r >> 2) + 4 * hi; }
__device__ __forceinline__ unsigned cvtpk(float lo, float hi) { unsigned r; asm volatile("v_cvt_pk_bf16_f32 %0, %1, %2" : "=v"(r) : "v"(lo), "v"(hi)); return r; }
__device__ __forceinline__ float bflo(unsigned w) { return __uint_as_float(w << 16); }
__device__ __forceinline__ float bfhi(unsigned w) { return __uint_as_float(w & 0xffff0000u); }
__device__ __forceinline__ int v_rd_base(int lane) { return ((lane & 3) << 3) | (((lane >> 2) & 3) << 6) | (((lane >> 4) & 1) << 5) | (((lane >> 5) & 1) << 8); }
constexpr int v_rd_off(int d0, int ks, int half) { return d0 * 512 + ks * 4096 + half * 2048; }
template <int OFF> __device__ __forceinline__ s16x4 tr_read(int vb) {
  s16x4 r; asm volatile("ds_read_b64_tr_b16 %0, %1 offset:%2" : "=&v"(r) : "v"(vb), "i"(OFF) : "memory"); return r;
}
template <int KS> __device__ __forceinline__ void pv_rd(s16x4 (&l)[4], s16x4 (&h)[4], int vb) {
  l[0] = tr_read<v_rd_off(0, KS, 0)>(vb); h[0] = tr_read<v_rd_off(0, KS, 1)>(vb); l[1] = tr_read<v_rd_off(1, KS, 0)>(vb); h[1] = tr_read<v_rd_off(1, KS, 1)>(vb);
  l[2] = tr_read<v_rd_off(2, KS, 0)>(vb); h[2] = tr_read<v_rd_off(2, KS, 1)>(vb); l[3] = tr_read<v_rd_off(3, KS, 0)>(vb); h[3] = tr_read<v_rd_off(3, KS, 1)>(vb);
}
#define ATT_PK(L, H) (bf16x8){L[0], L[1], L[2], L[3], H[0], H[1], H[2], H[3]}
__device__ __forceinline__ void pv_mm(f32x16 (&o)[4], bf16x8 pa, const s16x4 (&l)[4], const s16x4 (&h)[4]) {
#pragma unroll
  for (int d0 = 0; d0 < 4; ++d0) o[d0] = __builtin_amdgcn_mfma_f32_32x32x16_bf16(pa, ATT_PK(l[d0], h[d0]), o[d0], 0, 0, 0);
}
__device__ __forceinline__ void pv_all(f32x16 (&o)[4], int vb, bf16x8 pa0, bf16x8 pa1, bf16x8 pa2, bf16x8 pa3) {
  s16x4 la[4], ha[4], lb[4], hb[4];
  pv_rd<0>(la, ha, vb); pv_rd<1>(lb, hb, vb);
  asm volatile("s_waitcnt lgkmcnt(8)" ::: "memory"); ATT_SBAR();
  pv_mm(o, pa0, la, ha); ATT_SBAR();
  pv_rd<2>(la, ha, vb);
  asm volatile("s_waitcnt lgkmcnt(8)" ::: "memory"); ATT_SBAR();
  pv_mm(o, pa1, lb, hb); ATT_SBAR();
  pv_rd<3>(lb, hb, vb);
  asm volatile("s_waitcnt lgkmcnt(8)" ::: "memory"); ATT_SBAR();
  pv_mm(o, pa2, la, ha); ATT_SBAR();
  asm volatile("s_waitcnt lgkmcnt(0)" ::: "memory"); ATT_SBAR();
  pv_mm(o, pa3, lb, hb);
}
#undef ATT_PK
__device__ __forceinline__ void rot8(bf16x8& a, bf16x8& b, const f32x2* tab) {
  u32x4 ua = __builtin_bit_cast(u32x4, a), ub = __builtin_bit_cast(u32x4, b); u32x4 oa, ob;
#pragma unroll
  for (int w = 0; w < 4; ++w) {
    const f32x2 cs0 = tab[2 * w], cs1 = tab[2 * w + 1];
    const float a0 = bflo(ua[w]), a1 = bfhi(ua[w]), b0 = bflo(ub[w]), b1 = bfhi(ub[w]);
    oa[w] = cvtpk(a0 * cs0.x - b0 * cs0.y, a1 * cs1.x - b1 * cs1.y);
    ob[w] = cvtpk(b0 * cs0.x + a0 * cs0.y, b1 * cs1.x + a1 * cs1.y);
  }
  a = __builtin_bit_cast(bf16x8, oa); b = __builtin_bit_cast(bf16x8, ob);
}

template <int DQK, int MODE>
__device__ __forceinline__ void attn_unit(ATT_LAS unsigned char* lds, const bf16_t* Qs, int ldq, const bf16_t* Kn, int ldk, const bf16_t* Kr, const bf16_t* Vs, int ldv,
                                          bf16_t* Os, const f32x2* rope, int q0, int t_lo, int t_hi, float C, float thr, const float* sinkp, int tid_in) {
  constexpr int NR = (DQK - 128) / 16, NQ = DQK / 16;
  int tid_ = tid_in; asm volatile("" : "+v"(tid_));
  const int tid = tid_, lane = tid & 63, r32 = lane & 31, hi = lane >> 5; const int wid = __builtin_amdgcn_readfirstlane(tid >> 6);
  const int rowoff = (MODE == 1) ? (wid & 1) * 32 : wid * 32;
  float sinkl2 = 0.f;
  if (MODE == 1) { const int hs = wid >> 1; Qs += hs * 128; Os += hs * 128; sinkl2 = sinkp[hs] * 1.4426950408889634f; }
  ATT_LAS float* scr = (ATT_LAS float*)(lds + OFF_SCR) + wid * 64; ATT_LAS float* al_l = scr; ATT_LAS float* li_l = scr + 32;
  asm volatile("s_waitcnt vmcnt(0) lgkmcnt(0)\n\ts_barrier" ::: "memory");
  int offKn[2], offV[2], offKr = 0;
#pragma unroll
  for (int i = 0; i < 2; ++i) { const int p = 2 * wid + i;
    { const int row = 4 * p + (lane >> 4), c = (lane & 15) ^ (row & 15); offKn[i] = row * ldk + c * 8; }
    { const int sub = 2 * p + (lane >> 5), kk = (sub >> 2) * 8 + ((lane & 31) >> 2), k = (kk & ~0xC) | ((kk & 4) << 1) | ((kk & 8) >> 1), col = (sub & 3) * 32 + (lane & 3) * 8; offV[i] = k * ldv + col; } }
  if (NR > 0) { const int row = 8 * wid + (lane >> 3), c = (lane & 7) ^ ((row >> 1) & 7); offKr = row * 64 + c * 8; }
#define ATT_DMA(t, s) do { const size_t key0_ = (size_t)(t) * 64; ATT_LAS unsigned char* sl_ = lds + (s) * SLOT; \
    _Pragma("unroll") for (int i_ = 0; i_ < 2; ++i_) { \
      __builtin_amdgcn_global_load_lds((const unsigned*)(Kn + key0_ * ldk + offKn[i_]), (ATT_LAS unsigned*)(sl_ + OFF_KN + (2 * wid + i_) * 1024), 16, 0, 0); \
      __builtin_amdgcn_global_load_lds((const unsigned*)(Vs + key0_ * ldv + offV[i_]), (ATT_LAS unsigned*)(sl_ + OFF_V + (2 * wid + i_) * 1024), 16, 0, 0); } \
    if (NR > 0) __builtin_amdgcn_global_load_lds((const unsigned*)(Kr + key0_ * 64 + offKr), (ATT_LAS unsigned*)(sl_ + OFF_KR + wid * 1024), 16, 0, 0); } while (0)
  const int nT = t_hi - t_lo;
  ATT_DMA(t_lo, 0); if (nT > 1) ATT_DMA(t_lo + 1, 1);
  const int qpos = q0 + rowoff + r32;
  bf16x8 qr[NQ];
  { const bf16_t* qrow = Qs + (size_t)qpos * ldq + hi * 8;
#pragma unroll
    for (int d0 = 0; d0 < NQ; ++d0) qr[d0] = *(const bf16x8*)(qrow + d0 * 16);
    if (MODE == 0) { const f32x2* tb = rope + (size_t)qpos * 32 + hi * 8; rot8(qr[8], qr[10], tb); rot8(qr[9], qr[11], tb + 16); }
    else { const f32x2* tb = rope + (size_t)qpos * 16 + hi * 8; rot8(qr[0], qr[1], tb); } }
  float m_reg = -1e30f, l_reg = 0.f; f32x16 o[4];
#pragma unroll
  for (int d = 0; d < 4; ++d) o[d] = f32x16{};
  const int qw = q0 + rowoff;
#define ATT_QKC(P0, P1, SL, CH) do { if ((CH) < 8) { const int off_ = ((2 * (CH) + hi) ^ (r32 & 15)) << 4; const ATT_LAS unsigned char* kb_ = (SL) + OFF_KN + r32 * 256; \
        const bf16x8 b0_ = *(const ATT_LAS bf16x8*)(kb_ + off_), b1_ = *(const ATT_LAS bf16x8*)(kb_ + 8192 + off_); \
        P0 = __builtin_amdgcn_mfma_f32_32x32x16_bf16(b0_, qr[(CH)], P0, 0, 0, 0); P1 = __builtin_amdgcn_mfma_f32_32x32x16_bf16(b1_, qr[(CH)], P1, 0, 0, 0); } \
      else { const int off_ = ((2 * ((CH) - 8) + hi) ^ ((r32 >> 1) & 7)) << 4; const ATT_LAS unsigned char* kb_ = (SL) + OFF_KR + r32 * 128; \
        const bf16x8 b0_ = *(const ATT_LAS bf16x8*)(kb_ + off_), b1_ = *(const ATT_LAS bf16x8*)(kb_ + 4096 + off_); \
        P0 = __builtin_amdgcn_mfma_f32_32x32x16_bf16(b0_, qr[(CH) < NQ ? (CH) : 0], P0, 0, 0, 0); P1 = __builtin_amdgcn_mfma_f32_32x32x16_bf16(b1_, qr[(CH) < NQ ? (CH) : 0], P1, 0, 0, 0); } } while (0)
#define ATT_MASK(P0, P1, KEYLO) do { if (MODE == 1) { const int klo_ = (KEYLO); const bool full_ = (klo_ >= qw + 31 - 128) && (klo_ + 63 <= qw + 128); \
      if (!full_) { const int dq_ = klo_ + 4 * hi - qpos; \
        _Pragma("unroll") for (int r = 0; r < 16; ++r) { const int d_ = dq_ + (r & 3) + 8 * (r >> 2); \
          if (d_ > 128 || d_ < -128) P0[r] = -1e30f; if (d_ + 32 > 128 || d_ + 32 < -128) P1[r] = -1e30f; } } } } while (0)
#define ATT_PK4(P, BASE, OUT) do { unsigned a0_ = cvtpk(P[BASE + 0], P[BASE + 1]), a1_ = cvtpk(P[BASE + 2], P[BASE + 3]);   \
    unsigned b0_ = cvtpk(P[BASE + 4], P[BASE + 5]), b1_ = cvtpk(P[BASE + 6], P[BASE + 7]);                              \
    auto r0_ = __builtin_amdgcn_permlane32_swap(a0_, b0_, false, false); auto r1_ = __builtin_amdgcn_permlane32_swap(a1_, b1_, false, false); \
    u32x4 w_ = {r0_[0], r1_[0], r0_[1], r1_[1]}; OUT = __builtin_bit_cast(bf16x8, w_); } while (0)
#define ATT_XMAX(V) do { auto rr_ = __builtin_amdgcn_permlane32_swap(__float_as_uint(V), __float_as_uint(V), false, false); V = fmaxf(__uint_as_float(rr_[0]), __uint_as_float(rr_[1])); } while (0)
#define ATT_STEP(HASN, SLC, SLN, KEYLON) do { \
    const bool keep_ = __all(pm - m_reg <= thr); \
    const float mn_ = keep_ ? m_reg : fmaxf(m_reg, pm); \
    const float alpha_ = keep_ ? 1.0f : __builtin_amdgcn_exp2f((m_reg - mn_) * C); \
    m_reg = mn_; const float mnC_ = -mn_ * C; float ps_ = 0.f; \
    bf16x8 pa0_, pa1_, pa2_, pa3_; \
    if (HASN) { n0 = f32x16{}; n1 = f32x16{}; } \
    _Pragma("unroll") for (int c_ = 0; c_ < (NQ > 11 ? NQ : 11); ++c_) { \
      ATT_SBAR(); \
      if (HASN && c_ < NQ) ATT_QKC(n0, n1, SLN, c_); \
      if (c_ < 8) { _Pragma("unroll") for (int e_ = 0; e_ < 2; ++e_) { const int r_ = 2 * c_ + e_; \
          a0[r_] = __builtin_amdgcn_exp2f(fmaf(a0[r_], C, mnC_)); a1[r_] = __builtin_amdgcn_exp2f(fmaf(a1[r_], C, mnC_)); ps_ += a0[r_] + a1[r_]; } } \
      else if (c_ == 8) { auto rr_ = __builtin_amdgcn_permlane32_swap(__float_as_uint(ps_), __float_as_uint(ps_), false, false); ps_ = __uint_as_float(rr_[0]) + __uint_as_float(rr_[1]); l_reg = l_reg * alpha_ + ps_; } \
      else if (c_ == 9) { ATT_PK4(a0, 0, pa0_); ATT_PK4(a0, 8, pa1_); } \
      else if (c_ == 10) { ATT_PK4(a1, 0, pa2_); ATT_PK4(a1, 8, pa3_); } \
    } \
    ATT_SBAR(); \
    if (__any(alpha_ < 1.f)) { if (hi == 0) al_l[r32] = alpha_; asm volatile("s_waitcnt lgkmcnt(0)" ::: "memory"); \
      _Pragma("unroll") for (int r = 0; r < 16; ++r) { const float a_ = al_l[crow(r, hi)]; \
        _Pragma("unroll") for (int d = 0; d < 4; ++d) o[d][r] *= a_; } } \
    if (HASN) ATT_MASK(n0, n1, KEYLON); \
    { const int vb_ = (int)(uintptr_t)((SLC) + OFF_V) + v_rd_base(lane); float mx_ = -3.0e38f; \
      s16x4 la_[4], ha_[4], lb_[4], hb_[4]; \
      pv_rd<0>(la_, ha_, vb_); pv_rd<1>(lb_, hb_, vb_); \
      asm volatile("s_waitcnt lgkmcnt(8)" ::: "memory"); ATT_SBAR(); \
      pv_mm(o, pa0_, la_, ha_); if (HASN) { _Pragma("unroll") for (int r = 0; r < 8; ++r) mx_ = fmaxf(mx_, n0[r]); } ATT_SBAR(); \
      pv_rd<2>(la_, ha_, vb_); \
      asm volatile("s_waitcnt lgkmcnt(8)" ::: "memory"); ATT_SBAR(); \
      pv_mm(o, pa1_, lb_, hb_); if (HASN) { _Pragma("unroll") for (int r = 8; r < 16; ++r) mx_ = fmaxf(mx_, n0[r]); } ATT_SBAR(); \
      pv_rd<3>(lb_, hb_, vb_); \
      asm volatile("s_waitcnt lgkmcnt(8)" ::: "memory"); ATT_SBAR(); \
      pv_mm(o, pa2_, la_, ha_); if (HASN) { _Pragma("unroll") for (int r = 0; r < 8; ++r) mx_ = fmaxf(mx_, n1[r]); } ATT_SBAR(); \
      asm volatile("s_waitcnt lgkmcnt(0)" ::: "memory"); ATT_SBAR(); \
      pv_mm(o, pa3_, lb_, hb_); if (HASN) { _Pragma("unroll") for (int r = 8; r < 16; ++r) mx_ = fmaxf(mx_, n1[r]); ATT_XMAX(mx_); pmn = mx_; } ATT_SBAR(); } \
  } while (0)
  f32x16 a0 = f32x16{}, a1 = f32x16{}, n0, n1; float pm, pmn = 0.f;
  asm volatile("s_waitcnt vmcnt(0) lgkmcnt(0)\n\ts_barrier" ::: "memory");
  if (nT > 2) ATT_DMA(t_lo + 2, 2);
#pragma unroll
  for (int c = 0; c < NQ; ++c) ATT_QKC(a0, a1, lds, c);
  ATT_MASK(a0, a1, t_lo * 64);
  { float mx = a0[0];
#pragma unroll
    for (int r = 1; r < 16; ++r) mx = fmaxf(mx, a0[r]);
#pragma unroll
    for (int r = 0; r < 16; ++r) mx = fmaxf(mx, a1[r]);
    ATT_XMAX(mx); pm = mx; }
  int slot = 0;
  for (int jj = 0; jj + 1 < nT; ++jj) {
    ATT_LAS unsigned char* slc = lds + slot * SLOT; const int ns = slot == 2 ? 0 : slot + 1; ATT_LAS unsigned char* sln = lds + ns * SLOT;
    ATT_STEP(1, slc, sln, (t_lo + jj + 1) * 64);
    a0 = n0; a1 = n1; pm = pmn;
    asm volatile("s_waitcnt vmcnt(0) lgkmcnt(0)\n\ts_barrier" ::: "memory");
    if (jj + 3 < nT) ATT_DMA(t_lo + jj + 3, slot);
    slot = ns;
  }
  { ATT_LAS unsigned char* slc = lds + slot * SLOT; ATT_STEP(0, slc, slc, 0); }
#undef ATT_STEP
#undef ATT_XMAX
#undef ATT_PK4
#undef ATT_MASK
#undef ATT_QKC
  float lt = l_reg; if (MODE == 1) lt += __builtin_amdgcn_exp2f(sinkl2 - m_reg * C);
  if (hi == 0) li_l[r32] = lt; asm volatile("s_waitcnt lgkmcnt(0)" ::: "memory");
  bf16_t* Ow = Os + (size_t)(q0 + rowoff) * 2048 + r32;
#pragma unroll
  for (int r = 0; r < 16; ++r) { const int orow = crow(r, hi); const float rl = 1.0f / li_l[orow];
#pragma unroll
    for (int d0 = 0; d0 < 4; ++d0) { const unsigned w = cvtpk(o[d0][r] * rl, 0.f); Ow[(size_t)orow * 2048 + d0 * 32] = (bf16_t)(w & 0xffffu); } }
#undef ATT_DMA
}
}

namespace hy {
#define HY_LAS __attribute__((address_space(3)))
typedef float f32x2 __attribute__((ext_vector_type(2)));
typedef float f32x4 __attribute__((ext_vector_type(4)));
constexpr int OFF_A = 0, OFF_B = 32768, OFF_TW = 65536, NTWC = 2730, OFF_RED = OFF_TW + 22528, LDS_BYTES = OFF_RED + 256;
__device__ __forceinline__ int sw(int i) { return i ^ ((i >> 4) & 31); }
template <int LQ> __device__ __forceinline__ int swb(int g) {
  if (LQ == 8) return g ^ (g >> 4);
  if (LQ == 4) return (((g >> 4) << 8) + (g & 15)) ^ (((g >> 4) & 1) << 4);
  return (g << 4) ^ (g & 31);
}
template <int LQ> __host__ __device__ constexpr int swc(int j) { return LQ == 8 ? 256 * j + 16 * (j & 1) : (LQ == 4 ? 17 * j : j); }
__host__ __device__ constexpr int twb(int lh) { return 2 * ((4096 - (4 << (lh - 1))) / 3); }
__device__ __forceinline__ float fadd_s(float a, float b) { float r; asm("v_add_f32_e32 %0, %1, %2" : "=v"(r) : "v"(a), "v"(b)); return r; }
__device__ __forceinline__ float fsub_s(float a, float b) { float r; asm("v_sub_f32_e32 %0, %1, %2" : "=v"(r) : "v"(a), "v"(b)); return r; }
__device__ __forceinline__ float fmul_s(float a, float b) { float r; asm("v_mul_f32_e32 %0, %1, %2" : "=v"(r) : "v"(a), "v"(b)); return r; }
__device__ __forceinline__ float ffma_s(float a, float b, float c) { float r; asm("v_fma_f32 %0, %1, %2, %3" : "=v"(r) : "v"(a), "v"(b), "v"(c)); return r; }
__device__ __forceinline__ float fnma_s(float a, float b, float c) { float r; asm("v_fma_f32 %0, -%1, %2, %3" : "=v"(r) : "v"(a), "v"(b), "v"(c)); return r; }
__device__ __forceinline__ f32x2 cadd(f32x2 a, f32x2 b) { return (f32x2){fadd_s(a.x, b.x), fadd_s(a.y, b.y)}; }
__device__ __forceinline__ f32x2 csub(f32x2 a, f32x2 b) { return (f32x2){fsub_s(a.x, b.x), fsub_s(a.y, b.y)}; }
__device__ __forceinline__ f32x2 cmul(f32x2 a, f32x2 b) { return (f32x2){fnma_s(a.y, b.y, fmul_s(a.x, b.x)), ffma_s(a.y, b.x, fmul_s(a.x, b.y))}; }
__device__ __forceinline__ f32x2 cmulc(f32x2 a, f32x2 b) { return (f32x2){ffma_s(a.y, b.y, fmul_s(a.x, b.x)), fnma_s(a.x, b.y, fmul_s(a.y, b.x))}; }
#define HY_SYNC() do { asm volatile("s_waitcnt lgkmcnt(0)" ::: "memory"); __builtin_amdgcn_s_barrier(); asm volatile("" ::: "memory"); } while (0)
__device__ __forceinline__ void r4f(f32x2& x0, f32x2& x1, f32x2& x2, f32x2& x3, f32x2 w1, f32x2 w2) {
  const f32x2 a0 = cadd(x0, x2), a2 = cmul(csub(x0, x2), w1), a1 = cadd(x1, x3), t = cmul(csub(x1, x3), w1);
  x0 = cadd(a0, a1); x1 = cmul(csub(a0, a1), w2);
  x2 = (f32x2){fadd_s(a2.x, t.y), fsub_s(a2.y, t.x)};
  x3 = cmul((f32x2){fsub_s(a2.x, t.y), fadd_s(a2.y, t.x)}, w2);
}
__device__ __forceinline__ void r4f_z(f32x2& x0, f32x2& x1, f32x2& x2, f32x2& x3, f32x2 w1, f32x2 w2) {
  const f32x2 a0 = x0, a2 = cmul(x0, w1), a1 = x1, t = cmul(x1, w1);
  x0 = cadd(a0, a1); x1 = cmul(csub(a0, a1), w2);
  x2 = (f32x2){fadd_s(a2.x, t.y), fsub_s(a2.y, t.x)};
  x3 = cmul((f32x2){fsub_s(a2.x, t.y), fadd_s(a2.y, t.x)}, w2);
}
__device__ __forceinline__ void r4i(f32x2& x0, f32x2& x1, f32x2& x2, f32x2& x3, f32x2 w1, f32x2 w2) {
  const f32x2 t1 = cmulc(x1, w2), t3 = cmulc(x3, w2);
  const f32x2 b0 = cadd(x0, t1), b1 = csub(x0, t1), b2 = cmulc(cadd(x2, t3), w1), u = cmulc(csub(x2, t3), w1);
  x0 = cadd(b0, b2); x2 = csub(b0, b2);
  x1 = (f32x2){fsub_s(b1.x, u.y), fadd_s(b1.y, u.x)};
  x3 = (f32x2){fadd_s(b1.x, u.y), fsub_s(b1.y, u.x)};
}
template <int LQ, bool ZPAD> __device__ __forceinline__ void r16_fwd(f32x2 (&x)[16], const HY_LAS f32x2* TW, int pos) {
  constexpr int q = 1 << LQ, lh1 = LQ + 3, lh2 = LQ + 1;
#pragma unroll
  for (int jj = 0; jj < 4; ++jj) { const int p1 = pos + jj * q; const f32x2 w1 = TW[twb(lh1) + p1], w2 = TW[twb(lh1) + 4 * q + p1];
    if (ZPAD) r4f_z(x[jj], x[jj + 4], x[jj + 8], x[jj + 12], w1, w2); else r4f(x[jj], x[jj + 4], x[jj + 8], x[jj + 12], w1, w2); }
  { const f32x2 w1 = TW[twb(lh2) + pos], w2 = TW[twb(lh2) + q + pos];
#pragma unroll
    for (int m = 0; m < 4; ++m) r4f(x[4 * m], x[4 * m + 1], x[4 * m + 2], x[4 * m + 3], w1, w2); }
}
template <int LQ> __device__ __forceinline__ void r16_inv(f32x2 (&x)[16], const HY_LAS f32x2* TW, int pos) {
  constexpr int q = 1 << LQ, lh1 = LQ + 3, lh2 = LQ + 1;
  { const f32x2 w1 = TW[twb(lh2) + pos], w2 = TW[twb(lh2) + q + pos];
#pragma unroll
    for (int m = 0; m < 4; ++m) r4i(x[4 * m], x[4 * m + 1], x[4 * m + 2], x[4 * m + 3], w1, w2); }
#pragma unroll
  for (int jj = 0; jj < 4; ++jj) { const int p1 = pos + jj * q; const f32x2 w1 = TW[twb(lh1) + p1], w2 = TW[twb(lh1) + 4 * q + p1];
    r4i(x[jj], x[jj + 4], x[jj + 8], x[jj + 12], w1, w2); }
}
template <int LQ> __device__ __forceinline__ void grp(int g, int& base, int& pos) { pos = g & ((1 << LQ) - 1); base = ((g >> LQ) << (LQ + 4)) + pos; }
template <int LQ, bool ZPAD> __device__ __forceinline__ void pass_fwd(HY_LAS f32x2* X, const HY_LAS f32x2* TW, int g) {
  int base, pos; grp<LQ>(g, base, pos); f32x2 x[16]; const int sb = swb<LQ>(g);
#pragma unroll
  for (int j = 0; j < 16; ++j) x[j] = (ZPAD && j >= 8) ? (f32x2){0.f, 0.f} : X[sb ^ swc<LQ>(j)];
  r16_fwd<LQ, ZPAD>(x, TW, pos);
#pragma unroll
  for (int j = 0; j < 16; ++j) X[sb ^ swc<LQ>(j)] = x[j];
}
template <int LQ, bool HALF> __device__ __forceinline__ void pass_inv(HY_LAS f32x2* X, const HY_LAS f32x2* TW, int g) {
  int base, pos; grp<LQ>(g, base, pos); f32x2 x[16]; const int sb = swb<LQ>(g);
#pragma unroll
  for (int j = 0; j < 16; ++j) x[j] = X[sb ^ swc<LQ>(j)];
  r16_inv<LQ>(x, TW, pos);
#pragma unroll
  for (int j = 0; j < (HALF ? 8 : 16); ++j) X[sb ^ swc<LQ>(j)] = x[j];
}
__device__ __forceinline__ float bf2f(unsigned short x) { return __uint_as_float((unsigned)x << 16); }
__device__ __forceinline__ unsigned short f2bf(float f) { unsigned r; asm volatile("v_cvt_pk_bf16_f32 %0, %1, %2" : "=v"(r) : "v"(f), "v"(0.f)); return (unsigned short)(r & 0xffffu); }
__device__ __forceinline__ void load_tw(HY_LAS unsigned char* lds, const f32x2* twg, int tid) {
  HY_LAS f32x2* TW = (HY_LAS f32x2*)(lds + OFF_TW);
#pragma unroll
  for (int j = 0; j < 6; ++j) { const int i = tid + 512 * j; if (i < NTWC) TW[i] = twg[i]; }
}

__device__ __forceinline__ void khat_task(HY_LAS unsigned char* lds, const float* KF, f32x2* KH, int li, int cpair, int tid_in) {
  int tid_ = tid_in; asm volatile("" : "+v"(tid_)); const int tid = tid_;
  const int buf = tid >> 8, g = tid & 255, c = 2 * cpair + buf;
  const float* f0 = KF + ((size_t)li * 4096 + c) * 2048;
  const size_t DS = (size_t)1024 * 2048;
  HY_LAS f32x2* X = (HY_LAS f32x2*)(lds + OFF_A + 32768 * buf); const HY_LAS f32x2* TW = (const HY_LAS f32x2*)(lds + OFF_TW);
  float fv0[8], bv0[8], fv1[8], bv1[8]; float an0 = 0.f, an1 = 0.f;
#pragma unroll
  for (int j = 0; j < 8; ++j) { const int t = g + 256 * j; fv0[j] = f0[t]; bv0[j] = f0[DS + t]; fv1[j] = f0[2 * DS + t]; bv1[j] = f0[3 * DS + t]; }
#pragma unroll
  for (int j = 0; j < 8; ++j) { const int t = g + 256 * j; an0 += fabsf(fv0[j]) + (t >= 1 ? fabsf(bv0[j]) : 0.f); an1 += fabsf(fv1[j]) + (t >= 1 ? fabsf(bv1[j]) : 0.f); }
#define HY_WSUM(an) do { \
  an += __builtin_bit_cast(float, __builtin_amdgcn_update_dpp(0, __builtin_bit_cast(int, an), 0xB1, 0xF, 0xF, true)); \
  an += __builtin_bit_cast(float, __builtin_amdgcn_update_dpp(0, __builtin_bit_cast(int, an), 0x4E, 0xF, 0xF, true)); \
  an += __builtin_bit_cast(float, __builtin_amdgcn_update_dpp(0, __builtin_bit_cast(int, an), 0x141, 0xF, 0xF, true)); \
  an += __builtin_bit_cast(float, __builtin_amdgcn_update_dpp(0, __builtin_bit_cast(int, an), 0x140, 0xF, 0xF, true)); \
  an += __builtin_bit_cast(float, __builtin_amdgcn_ds_swizzle(__builtin_bit_cast(int, an), 0x401F)); \
  { auto rr = __builtin_amdgcn_permlane32_swap(__float_as_uint(an), __float_as_uint(an), false, false); an = __uint_as_float(rr[0]) + __uint_as_float(rr[1]); } } while (0)
  HY_WSUM(an0); HY_WSUM(an1);
#undef HY_WSUM
  HY_LAS float* red = (HY_LAS float*)(lds + OFF_RED);
  if ((tid & 63) == 0) { red[(tid >> 6) * 2] = an0; red[(tid >> 6) * 2 + 1] = an1; }
  HY_SYNC();
  const float tot0 = red[buf * 8] + red[buf * 8 + 2] + red[buf * 8 + 4] + red[buf * 8 + 6], tot1 = red[buf * 8 + 1] + red[buf * 8 + 3] + red[buf * 8 + 5] + red[buf * 8 + 7];
  const float inv0 = 1.0f / (tot0 * 4096.0f), inv1 = 1.0f / (tot1 * 4096.0f);
#pragma unroll
  for (int j = 0; j < 8; ++j) { const int t = g + 256 * j; X[sw(t)] = (f32x2){fv0[j] * inv0, fv1[j] * inv1}; if (t >= 1) X[sw(4096 - t)] = (f32x2){bv0[j] * inv0, bv1[j] * inv1}; }
  if (g == 0) { float z0 = 0.f; asm volatile("" : "+v"(z0)); X[sw(2048)] = (f32x2){z0, z0}; }
  HY_SYNC();
  pass_fwd<8, false>(X, TW, g); HY_SYNC();
  pass_fwd<4, false>(X, TW, g); HY_SYNC();
  pass_fwd<0, false>(X, TW, g); HY_SYNC();
  { f32x4* d0 = (f32x4*)(KH + ((size_t)(li * 2 + 0) * 1024 + c) * 4096 + 16 * g); f32x4* d1 = (f32x4*)(KH + ((size_t)(li * 2 + 1) * 1024 + c) * 4096 + 16 * g);
#pragma unroll
    for (int jp = 0; jp < 8; ++jp) { f32x2 k0[2], k1[2];
#pragma unroll
      for (int e = 0; e < 2; ++e) { const int p = 16 * g + 2 * jp + e; const int fq = (int)(__brev((unsigned)p) >> 20), pp = (int)(__brev((unsigned)((4096 - fq) & 4095)) >> 20);
        const f32x2 z = X[sw(p)], zp = X[sw(pp)];
        k0[e] = (f32x2){0.5f * (z.x + zp.x), 0.5f * (z.y - zp.y)}; k1[e] = (f32x2){0.5f * (z.y + zp.y), 0.5f * (zp.x - z.x)}; }
      d0[jp] = (f32x4){k0[0].x, k0[0].y, k0[1].x, k0[1].y}; d1[jp] = (f32x4){k1[0].x, k1[0].y, k1[1].x, k1[1].y}; } }
  HY_SYNC();
}

__device__ __forceinline__ void hyena_unit(HY_LAS unsigned char* lds, const unsigned short* UT, const f32x2* KH, const float* skip, unsigned short* MIXo, int c0, int tid_in) {
  int tid_ = tid_in; asm volatile("" : "+v"(tid_)); const int tid = tid_;
  const int buf = tid >> 8, g = tid & 255;
  HY_LAS f32x2* X = (HY_LAS f32x2*)(lds + OFF_A + 32768 * buf);
  const HY_LAS f32x2* TW = (const HY_LAS f32x2*)(lds + OFF_TW);
  unsigned W01[16], W23[16];
#pragma unroll
  for (int i = 0; i < 16; ++i) { W01[i] = 0u; W23[i] = 0u; }
  const size_t PART = (size_t)4 * 1024 * 2048, BST = (size_t)1024 * 2048;
  const unsigned short* ub = UT + (size_t)(2 * buf) * BST + g;
  int base0, pos0; grp<0>(g, base0, pos0); const int sb8 = swb<8>(g), sb0 = swb<0>(g);
  unsigned vraw[8];
#pragma unroll
  for (int j = 0; j < 8; ++j) vraw[j] = (unsigned)ub[(size_t)c0 * 2048 + 256 * j] | ((unsigned)ub[BST + (size_t)c0 * 2048 + 256 * j] << 16);
#pragma unroll 1
  for (int cc = 0; cc < 4; ++cc) {
    const int c = c0 + cc;
    f32x2 zc[8];
#pragma unroll 1
    for (int o = 0; o < 2; ++o) {
      const float sk = skip[o * 1024 + c];
      f32x2 x[16];
      if (o == 0) {
#pragma unroll
        for (int j = 0; j < 8; ++j) x[j] = (f32x2){__uint_as_float(vraw[j] << 16), __uint_as_float(vraw[j] & 0xffff0000u)};
      } else {
#pragma unroll
        for (int j = 0; j < 8; ++j) x[j] = zc[j];
      }
#pragma unroll
      for (int j = 8; j < 16; ++j) x[j] = (f32x2){0.f, 0.f};
      r16_fwd<8, true>(x, TW, g);
#pragma unroll
      for (int j = 0; j < 16; ++j) X[sb8 ^ swc<8>(j)] = x[j];
      HY_SYNC();
      f32x4 kk[8];
      { const f32x4* kp = (const f32x4*)(KH + ((size_t)o * 1024 + c) * 4096 + base0);
#pragma unroll
        for (int j = 0; j < 8; ++j) kk[j] = kp[j]; }
      pass_fwd<4, false>(X, TW, g); HY_SYNC();
      {
#pragma unroll
        for (int j = 0; j < 16; ++j) x[j] = X[sb0 ^ swc<0>(j)];
        r16_fwd<0, false>(x, TW, pos0);
#pragma unroll
        for (int j = 0; j < 8; ++j) { x[2 * j] = cmul(x[2 * j], (f32x2){kk[j][0], kk[j][1]}); x[2 * j + 1] = cmul(x[2 * j + 1], (f32x2){kk[j][2], kk[j][3]}); }
        r16_inv<0>(x, TW, pos0);
#pragma unroll
        for (int j = 0; j < 16; ++j) X[sb0 ^ swc<0>(j)] = x[j]; }
      HY_SYNC();
      unsigned graw[8];
      { const unsigned short* gp = ub + (size_t)(o + 1) * PART + (size_t)c * 2048;
#pragma unroll
        for (int j = 0; j < 8; ++j) graw[j] = (unsigned)gp[256 * j] | ((unsigned)gp[BST + 256 * j] << 16); }
      if (o == 1 && cc < 3) {
#pragma unroll
        for (int j = 0; j < 8; ++j) vraw[j] = (unsigned)ub[(size_t)(c + 1) * 2048 + 256 * j] | ((unsigned)ub[BST + (size_t)(c + 1) * 2048 + 256 * j] << 16);
      }
      pass_inv<4, false>(X, TW, g); HY_SYNC();
#pragma unroll
      for (int j = 0; j < 16; ++j) x[j] = X[sb8 ^ swc<8>(j)];
      r16_inv<8>(x, TW, g);
#pragma unroll
      for (int j = 0; j < 8; ++j) {
        const float g0 = __uint_as_float(graw[j] << 16), g1 = __uint_as_float(graw[j] & 0xffff0000u);
        if (o == 0) { zc[j] = (f32x2){g0 * (x[j].x + sk * __uint_as_float(vraw[j] << 16)), g1 * (x[j].y + sk * __uint_as_float(vraw[j] & 0xffff0000u))}; }
        else { const float r0 = g0 * (x[j].x + sk * zc[j].x), r1 = g1 * (x[j].y + sk * zc[j].y);
          const unsigned h0 = f2bf(r0), h1 = f2bf(r1);
          if (cc == 0) { W01[2 * j] = h0; W01[2 * j + 1] = h1; } else if (cc == 1) { W01[2 * j] |= h0 << 16; W01[2 * j + 1] |= h1 << 16; }
          else if (cc == 2) { W23[2 * j] = h0; W23[2 * j + 1] = h1; } else { W23[2 * j] |= h0 << 16; W23[2 * j + 1] |= h1 << 16; } }
      }
      HY_SYNC();
    }
  }
#pragma unroll
  for (int j = 0; j < 8; ++j)
#pragma unroll
    for (int e = 0; e < 2; ++e) { const int s = g + 256 * j, b = 2 * buf + e;
      unsigned long long w = (unsigned long long)W01[2 * j + e] | ((unsigned long long)W23[2 * j + e] << 32);
      *(unsigned long long*)(MIXo + ((size_t)b * 2048 + s) * 2048 + 1024 + c0) = w; }
}
}

constexpr int NWAVES = 8;
#define PG8_SP2 true
#define PG8_ALIGN true
#ifndef MK_MULTI
#define MK_MULTI 0
#endif
constexpr int D = 2048, NB = 4, SEQ = 2048, M = NB * SEQ, DFF = 8192, DEPTH = 4;
constexpr int EIN = 3904, EINP = 4096, QL_W = 512, KVL_W = 256, NQ_MLA = 1536, NKV_MLA = 2048, NQKV = 3072;
constexpr float RMS_EPS = 1e-6f;

constexpr size_t MiB = 1u << 20;
constexpr size_t WS_CTL = 0, CTL_ZERO_BYTES = 4 * MiB;
constexpr size_t CTL_ROWSS_OFF = 64 * 1024;
constexpr size_t CTL_ROWSS2_OFF = 320 * 1024;
constexpr size_t CTL_BIAS7_OFF = 2 * MiB;
constexpr size_t CTL_BIAS1_OFF = 2 * MiB + 512 * 1024;
constexpr size_t CTL_MOD_OFF = 1 * MiB;
constexpr size_t WS_WIN = 4 * MiB;
constexpr size_t WS_WOUT = WS_WIN + 128 * MiB;
constexpr size_t WS_WEIN = WS_WOUT + 128 * MiB;
constexpr size_t WS_WEOUT = WS_WEIN + 32 * MiB;
constexpr size_t WS_WQKV = WS_WEOUT + 16 * MiB;
constexpr size_t WS_WO = WS_WQKV + 24 * MiB;
constexpr size_t WS_WUQ = WS_WO + 16 * MiB;
constexpr size_t WS_WUKV = WS_WUQ + 3 * MiB;
constexpr size_t WS_H = WS_WUKV + 2 * MiB;
constexpr size_t WS_Z = WS_H + 32 * MiB;
constexpr size_t WS_Q = WS_Z + 64 * MiB;
constexpr size_t WS_KV = WS_Q + 24 * MiB;
constexpr size_t WS_KR = WS_KV + 32 * MiB;
constexpr size_t WS_QL = WS_KR + 1 * MiB;
constexpr size_t WS_KVL = WS_QL + 8 * MiB;
constexpr size_t WS_UT = WS_KVL + 4 * MiB;
constexpr size_t WS_MIX = WS_UT + 48 * MiB;
constexpr size_t WS_HID = WS_MIX + 32 * MiB;
constexpr size_t WS_KF = WS_HID + 128 * MiB;
constexpr size_t WS_H3 = WS_KF + 64 * MiB;
constexpr size_t WS_W4T = WS_H3 + 1 * MiB;
constexpr size_t WS_ROPE64 = WS_W4T + 2 * MiB;
constexpr size_t WS_ROPE32 = WS_ROPE64 + 1 * MiB;
constexpr size_t WS_TW = WS_ROPE32 + 1 * MiB;
constexpr size_t WS_KH = WS_TW + 1 * MiB;
constexpr size_t WS_END = WS_KH + 128 * MiB;
constexpr int CW_TMO = 0, CW_BAR = 4096;

constexpr int RING_BYTES = 139264;
constexpr int LDSCTL_OFF = RING_BYTES, MISC_OFF = LDSCTL_OFF + 320;
constexpr int LDS_BYTES = 143360;
static_assert(MISC_OFF + 128 <= LDS_BYTES && att::LDS_BYTES <= RING_BYTES && hy::LDS_BYTES <= RING_BYTES && pg8::STAGE_BYTES <= RING_BYTES, "LDS map");

#define GAS __attribute__((address_space(1)))
#define LAS __attribute__((address_space(3)))
typedef unsigned short bf16;
typedef unsigned v4u __attribute__((ext_vector_type(4)));
typedef unsigned v2u __attribute__((ext_vector_type(2)));
typedef float f32x4 __attribute__((ext_vector_type(4)));
typedef float f32x2 __attribute__((ext_vector_type(2)));
typedef GAS unsigned gu32;
#define RLX_AGENT __ATOMIC_RELAXED, __HIP_MEMORY_SCOPE_AGENT
#define LDS_WAIT() asm volatile("s_waitcnt lgkmcnt(0)" ::: "memory")
#define VM_WAIT() asm volatile("s_waitcnt vmcnt(0)" ::: "memory")
__device__ __forceinline__ unsigned pk2(float lo, float hi) { unsigned r; asm volatile("v_cvt_pk_bf16_f32 %0, %1, %2" : "=v"(r) : "v"(lo), "v"(hi)); return r; }
__device__ __forceinline__ float bflo(unsigned w) { return __uint_as_float(w << 16); }
__device__ __forceinline__ float bfhi(unsigned w) { return __uint_as_float(w & 0xffff0000u); }
__device__ __forceinline__ float wave_sum(float v) {
    v += __builtin_bit_cast(float, __builtin_amdgcn_update_dpp(0, __builtin_bit_cast(int, v), 0xB1, 0xF, 0xF, true));
    v += __builtin_bit_cast(float, __builtin_amdgcn_update_dpp(0, __builtin_bit_cast(int, v), 0x4E, 0xF, 0xF, true));
    v += __builtin_bit_cast(float, __builtin_amdgcn_update_dpp(0, __builtin_bit_cast(int, v), 0x141, 0xF, 0xF, true));
    v += __builtin_bit_cast(float, __builtin_amdgcn_update_dpp(0, __builtin_bit_cast(int, v), 0x140, 0xF, 0xF, true));
    v += __builtin_bit_cast(float, __builtin_amdgcn_ds_swizzle(__builtin_bit_cast(int, v), 0x401F));
    { auto rr = __builtin_amdgcn_permlane32_swap(__float_as_uint(v), __float_as_uint(v), false, false); v = __uint_as_float(rr[0]) + __uint_as_float(rr[1]); }
    return v;
}

#ifndef PROBE_CVT
#define PROBE_CVT 0
#endif
#ifndef PROBE_ADA
#define PROBE_ADA 0
#endif
#ifndef PROBE_TAB
#define PROBE_TAB 0
#endif
#ifndef PROBE_NORM
#define PROBE_NORM 0
#endif
#ifndef PROBE_KF
#define PROBE_KF 0
#endif
#ifndef PROBE_G1
#define PROBE_G1 0
#endif
#ifndef PROBE_E3
#define PROBE_E3 0
#endif
#ifndef PROBE_G3
#define PROBE_G3 0
#endif
#ifndef PROBE_MLA
#define PROBE_MLA 0
#endif
#ifndef PROBE_HY
#define PROBE_HY 0
#endif
#ifndef PROBE_GQA
#define PROBE_GQA 0
#endif
#ifndef PROBE_G5
#define PROBE_G5 0
#endif
#ifndef PROBE_G7
#define PROBE_G7 0
#endif
#ifndef PROBE_G8
#define PROBE_G8 0
#endif
#ifndef PROBE_BAR
#define PROBE_BAR 0
#endif
#ifndef PROBE_KH
#define PROBE_KH 0
#endif
#ifndef PROBE_GK
#define PROBE_GK 0
#endif
#ifndef PROBE_FIN
#define PROBE_FIN 0
#endif
#define REP(n) _Pragma("unroll 1") for (int rep_ = 0; rep_ < 1 + PROBE_##n; ++rep_)
#define XB_TMO      128
#define XB_XCNT(j)  (256  + 64 * (j))
#define XB_XSUB(j)  (1280 + 64 * (j))
#define XB_XGEN(j)  (2304 + 64 * (j))
#define XB_TOP      3328
#define XB_TOPGEN   3392
#define XCD_BAR_WORDS 3456
#define XB_SPIN_CAP (1u << 18)

__device__ __forceinline__ unsigned xb_ld(unsigned* p)              { return __hip_atomic_load(p, __ATOMIC_RELAXED, __HIP_MEMORY_SCOPE_AGENT); }
__device__ __forceinline__ unsigned xb_add(unsigned* p, unsigned v) { return __hip_atomic_fetch_add(p, v, __ATOMIC_RELAXED, __HIP_MEMORY_SCOPE_AGENT); }
__device__ __forceinline__ unsigned xb_xcc_id() { return (unsigned)__builtin_amdgcn_s_getreg((3 << 11) | 20) & 0xFu; }
#define XB_SPIN(cond, bar) do { unsigned _sp = 0; while (cond) { __builtin_amdgcn_s_sleep(1); \
    if ((++_sp & 255u) == 0u) { if (xb_ld(&(bar)[XB_TMO])) break; if (_sp > XB_SPIN_CAP) { atomicAdd(&(bar)[XB_TMO], 1u); break; } } } } while (0)

struct XcdBarrier {
    unsigned* bar; unsigned x;
    volatile LAS unsigned* st;
};

__device__ __forceinline__ XcdBarrier xcd_barrier_post(unsigned* bar, volatile LAS unsigned* st) {
    XcdBarrier b; b.bar = bar; b.x = xb_xcc_id(); b.st = st;
    if (threadIdx.x == 0) (void)xb_add(&bar[XB_XCNT(b.x)], 1u);
    return b;
}
__device__ __forceinline__ void xcd_barrier_complete(unsigned* bar, unsigned x, unsigned& nloc, unsigned& nx) {
    const unsigned G = gridDim.x * gridDim.y * gridDim.z;
    unsigned sum, cnt, mine, sp = 0u;
    for (;;) {
        sum = 0u; cnt = 0u; mine = 0u;
#pragma unroll 1
        for (unsigned j = 0; j < 16; ++j) { const unsigned c = xb_ld(&bar[XB_XCNT(j)]); sum += c; cnt += (c > 0u) ? 1u : 0u; mine = (j == x) ? c : mine; }
        if (sum == G) break;
        __builtin_amdgcn_s_sleep(1);
        if ((++sp & 255u) == 0u) { if (xb_ld(&bar[XB_TMO])) break; if (sp > XB_SPIN_CAP) { atomicAdd(&bar[XB_TMO], 1u); break; } }
    }
    nloc = mine > 0u ? mine : 1u; nx = cnt > 0u ? cnt : 1u;
}

__device__ __forceinline__ void xcd_barrier(const XcdBarrier& b, const bool is_thread0  ) {
    asm volatile("s_waitcnt vmcnt(0)" ::: "memory");
    __syncthreads();
    if (is_thread0) {
        unsigned* bar = b.bar;
        __builtin_amdgcn_s_waitcnt(0);
        unsigned nloc = b.st[0], nx = b.st[1];
        if (nloc == 0u) { xcd_barrier_complete(bar, b.x, nloc, nx); b.st[0] = nloc; b.st[1] = nx; }
        const unsigned old = xb_add(&bar[XB_XSUB(b.x)], 1u);
        const unsigned gen = old / nloc;
        if (old + 1u == (gen + 1u) * nloc) {
            __builtin_amdgcn_fence(__ATOMIC_RELEASE, "agent");
            asm volatile("s_waitcnt vmcnt(0)" ::: "memory");
            const unsigned og = xb_add(&bar[XB_TOP], 1u);
            const unsigned tg = og / nx;
            if (og + 1u == (tg + 1u) * nx) xb_add(&bar[XB_TOPGEN], 1u);
            else XB_SPIN(xb_ld(&bar[XB_TOPGEN]) == tg, bar);
            __builtin_amdgcn_fence(__ATOMIC_ACQUIRE, "agent");
            xb_add(&bar[XB_XGEN(b.x)], 1u);
            asm volatile("s_waitcnt vmcnt(0)" ::: "memory");
        } else {
            XB_SPIN(xb_ld(&bar[XB_XGEN(b.x)]) == gen, bar);
            __builtin_amdgcn_fence(__ATOMIC_ACQUIRE, "agent");
            asm volatile("s_waitcnt vmcnt(0)" ::: "memory");
        }
    }
    __syncthreads();
}

struct Frame {
    LAS unsigned char* lds;
    volatile LAS unsigned* MISC;
    gu32* ctl;
    int tid, lane, wave;
    int vcu, G;
    unsigned char* ws;
};
struct Args { const float* in[31]; float* out; unsigned char* ws; int ph_lo, ph_hi; };

struct CvtD { const float* W; bf16* WT; const float* kscale; const float* shiftp; float* biasp; int K, N, bstride, item; };
__device__ __forceinline__ void cvt_load(const CvtD& d, int lane, f32x4 (&v)[16]) {
    const int nblk = d.N >> 6, kb = d.item / nblk, nb = d.item - kb * nblk, k0 = kb << 6, n0 = nb << 6;
#pragma unroll
    for (int i = 0; i < 16; ++i) v[i] = *(const GAS f32x4*)(d.W + (size_t)(k0 + 4 * i + (lane >> 4)) * d.N + n0 + 4 * (lane & 15));
}
__device__ __forceinline__ void cvt_store(const CvtD& d, LAS float* scr, int lane, const f32x4 (&v)[16]) {
    const int K = d.K, nblk = d.N >> 6, kb = d.item / nblk, nb = d.item - kb * nblk, k0 = kb << 6, n0 = nb << 6;
#pragma unroll
    for (int i = 0; i < 16; ++i) { const int kl = 4 * i + (lane >> 4); f32x4 x = v[i]; if (d.kscale) { const float s = d.kscale[k0 + kl]; x = x * s; }
        LAS float* q = scr + kl * 65 + 4 * (lane & 15); q[0] = x[0]; q[1] = x[1]; q[2] = x[2]; q[3] = x[3]; }
    LDS_WAIT(); asm volatile("" ::: "memory");
    if (d.shiftp) {
        float sh[4], ab[4];
#pragma unroll
        for (int b = 0; b < 4; ++b) { sh[b] = d.shiftp[(size_t)b * 6144 + k0 + lane]; ab[b] = 0.f; }
#pragma unroll
        for (int k = 0; k < 64; ++k) { const float w = scr[k * 65 + lane];
#pragma unroll
            for (int b = 0; b < 4; ++b) ab[b] += __builtin_bit_cast(float, __builtin_amdgcn_readlane(__builtin_bit_cast(int, sh[b]), k)) * w; }
#pragma unroll
        for (int b = 0; b < 4; ++b) __hip_atomic_fetch_add(d.biasp + (size_t)b * d.bstride + n0 + lane, ab[b], __ATOMIC_RELAXED, __HIP_MEMORY_SCOPE_AGENT);
    }
    const int c = lane >> 3;
#pragma unroll
    for (int i = 0; i < 8; ++i) { const int n = (lane & 7) + 8 * i; const LAS float* sp = scr + (8 * c) * 65 + n;
        v4u o; o.x = pk2(sp[0 * 65], sp[1 * 65]); o.y = pk2(sp[2 * 65], sp[3 * 65]); o.z = pk2(sp[4 * 65], sp[5 * 65]); o.w = pk2(sp[6 * 65], sp[7 * 65]);
        *(GAS v4u*)(d.WT + (size_t)(n0 + n) * K + k0 + 8 * c) = o; }
    LDS_WAIT(); asm volatile("" ::: "memory");
}

__device__ __forceinline__ void p0_ada(Frame& F, const Args& a) {
    unsigned char* ws = F.ws;
    const int gw = F.vcu * NWAVES + F.wave, NGW = F.G * NWAVES;
    REP(ADA) {
        LAS float* sc = (LAS float*)(F.lds + F.wave * 8192);
        LAS float* tr = sc + 512;
        float* mod = rep_ == PROBE_ADA ? (float*)(ws + CTL_MOD_OFF) : (float*)(ws + WS_END);
        const float* cin = a.in[1];
        for (int t = gw; t < 8 * 32 * 24; t += NGW) {
            const int aa = t / (32 * 24), r = t - aa * (32 * 24), kc = r / 24, nc = r - kc * 24;
            const int l = aa >> 1, sub = aa & 1;
            const float* Wm = (sub ? a.in[5] : a.in[2]) + (size_t)l * D * 6144;
            const float* bias = (sub ? a.in[6] : a.in[3]) + (size_t)l * 6144;
#pragma unroll
            for (int j = 0; j < 4; ++j) { const int idx = F.lane + 64 * j; const int b = idx & 3, kk = idx >> 2;
                const float x = cin[b * D + kc * 64 + kk]; sc[kk * 4 + b] = x / (1.0f + __expf(-x)); }
            LDS_WAIT(); asm volatile("" ::: "memory");
            f32x4 acc[4];
#pragma unroll
            for (int b = 0; b < 4; ++b) acc[b] = (f32x4){0.f, 0.f, 0.f, 0.f};
            const float* wp = Wm + (size_t)(kc * 64) * 6144 + nc * 256 + 4 * F.lane;
#pragma unroll 1
            for (int k0 = 0; k0 < 64; k0 += 32) {
                f32x4 w[32];
#pragma unroll
                for (int k = 0; k < 32; ++k) w[k] = *(const GAS f32x4*)(wp + (size_t)(k0 + k) * 6144);
#pragma unroll
                for (int k = 0; k < 32; ++k) { const f32x4 s = *(const LAS f32x4*)(sc + (k0 + k) * 4);
#pragma unroll
                    for (int b = 0; b < 4; ++b) acc[b] += w[k] * s[b]; } }
            if (kc == 0) { const f32x4 bv = *(const GAS f32x4*)(bias + nc * 256 + 4 * F.lane);
#pragma unroll
                for (int b = 0; b < 4; ++b) acc[b] += bv; }
#pragma unroll
            for (int b = 0; b < 4; ++b) *(LAS f32x4*)(tr + b * 256 + 4 * F.lane) = acc[b];
            LDS_WAIT(); asm volatile("" ::: "memory");
#pragma unroll
            for (int b = 0; b < 4; ++b)
#pragma unroll
                for (int j = 0; j < 4; ++j) { const float v = tr[b * 256 + F.lane + 64 * j];
                    __hip_atomic_fetch_add(mod + ((size_t)aa * 4 + b) * 6144 + nc * 256 + F.lane + 64 * j, v, __ATOMIC_RELAXED, __HIP_MEMORY_SCOPE_AGENT); }
            LDS_WAIT(); asm volatile("" ::: "memory");
        }
    }
}
__device__ __forceinline__ void p0_convert(Frame& F, const Args& a) {
    unsigned char* ws = F.ws;
    const int gw = F.vcu * NWAVES + F.wave, NGW = F.G * NWAVES;
    const float* MODp = (const float*)(ws + CTL_MOD_OFF); float* B7 = (float*)(ws + CTL_BIAS7_OFF); float* B1 = (float*)(ws + CTL_BIAS1_OFF);
    REP(CVT) {
        LAS float* scr = (LAS float*)(F.lds + F.wave * 16640);
        constexpr int I_IN = 32 * 128, I_OUT = 128 * 32, I_EIN = 32 * 61, I_EOUT = 32 * 32, I_QKV = 32 * 48, I_WO = 32 * 32, I_UQ = 8 * 24, I_UKV = 4 * 32;
        constexpr int T0 = 4 * I_IN, T1 = T0 + 4 * I_OUT, T2 = T1 + 2 * I_EIN, T3 = T2 + 2 * I_EOUT, T4 = T3 + 2 * I_QKV, T5 = T4 + 2 * I_WO, T6 = T5 + 2 * I_UQ, T7 = T6 + 2 * I_UKV;
        const bool bias_on = (rep_ == PROBE_CVT);
        auto desc = [&](int it) -> CvtD {
            CvtD d; d.kscale = nullptr; d.shiftp = nullptr; d.biasp = nullptr; d.bstride = 0;
            if (it < T0) { const int l = it / I_IN; d.item = it - l * I_IN; d.W = a.in[8] + (size_t)l * D * DFF; d.K = D; d.N = DFF; d.WT = (bf16*)(ws + WS_WIN) + (size_t)l * DFF * D;
                if (bias_on) { d.shiftp = MODp + (size_t)(2 * l + 1) * 4 * 6144; d.biasp = B7 + (size_t)l * 4 * 8192; d.bstride = 8192; } }
            else if (it < T1) { const int q = it - T0, l = q / I_OUT; d.item = q - l * I_OUT; d.W = a.in[9] + (size_t)l * DFF * D; d.K = DFF; d.N = D; d.WT = (bf16*)(ws + WS_WOUT) + (size_t)l * D * DFF; }
            else if (it < T2) { const int q = it - T1, l = q / I_EIN; d.item = q - l * I_EIN; d.W = a.in[10] + (size_t)l * D * EIN; d.K = D; d.N = EIN; d.WT = (bf16*)(ws + WS_WEIN) + (size_t)l * EINP * D;
                if (bias_on && l > 0) { d.shiftp = MODp + (size_t)(4 * l) * 4 * 6144; d.biasp = B1 + (size_t)(2 * l) * 4 * 4096; d.bstride = 4096; } }
            else if (it < T3) { const int q = it - T2, l = q / I_EOUT; d.item = q - l * I_EOUT; d.W = a.in[26] + (size_t)l * D * D; d.K = D; d.N = D; d.WT = (bf16*)(ws + WS_WEOUT) + (size_t)l * D * D; }
            else if (it < T4) { const int q = it - T3, l = q / I_QKV; d.item = q - l * I_QKV; d.W = a.in[27] + (size_t)l * D * NQKV; d.K = D; d.N = NQKV; d.WT = (bf16*)(ws + WS_WQKV) + (size_t)l * NQKV * D;
                if (bias_on) { d.shiftp = MODp + (size_t)(4 * l + 2) * 4 * 6144; d.biasp = B1 + (size_t)(2 * l + 1) * 4 * 4096; d.bstride = 4096; } }
            else if (it < T5) { const int q = it - T4, l = q / I_WO; d.item = q - l * I_WO; d.W = a.in[29] + (size_t)l * D * D; d.K = D; d.N = D; d.WT = (bf16*)(ws + WS_WO) + (size_t)l * D * D; }
            else if (it < T6) { const int q = it - T5, l = q / I_UQ; d.item = q - l * I_UQ; d.W = a.in[13] + (size_t)l * QL_W * NQ_MLA; d.K = QL_W; d.N = NQ_MLA; d.WT = (bf16*)(ws + WS_WUQ) + (size_t)l * NQ_MLA * QL_W; d.kscale = a.in[11] + l * QL_W; }
            else { const int q = it - T6, l = q / I_UKV; d.item = q - l * I_UKV; d.W = a.in[14] + (size_t)l * KVL_W * NKV_MLA; d.K = KVL_W; d.N = NKV_MLA; d.WT = (bf16*)(ws + WS_WUKV) + (size_t)l * NKV_MLA * KVL_W; d.kscale = a.in[12] + l * KVL_W; }
            return d; };
        int it = gw;
        if (it < T7) {
            CvtD d = desc(it); f32x4 v[16]; cvt_load(d, F.lane, v);
            for (;;) {
                const int itn = it + NGW; const bool hn = itn < T7; CvtD dn = d; f32x4 vn[16];
                if (hn) { dn = desc(itn); cvt_load(dn, F.lane, vn); }
                cvt_store(d, scr, F.lane, v);
                if (!hn) break;
                d = dn; it = itn;
#pragma unroll
                for (int i = 0; i < 16; ++i) v[i] = vn[i];
            }
        }
    }
}

__device__ __forceinline__ void p0_tables(Frame& F, const Args& a) {
    unsigned char* ws = F.ws;
    const int gw = F.vcu * NWAVES + F.wave, NGW = F.G * NWAVES;
    {
        const int gt = F.vcu * (NWAVES * 64) + F.tid, NT = F.G * NWAVES * 64;
        f32x2* r64 = (f32x2*)(ws + WS_ROPE64); f32x2* r32 = (f32x2*)(ws + WS_ROPE32); f32x2* tw = (f32x2*)(ws + WS_TW);
        for (int i = gt; i < 2048 * 32; i += NT) { const int pos = i >> 5, k = i & 31; const float inv = (float)exp(-(double)k / 32.0 * log(500000.0)); const float ang = (float)pos * inv;
            r64[i] = (f32x2){(float)cos((double)ang), (float)sin((double)ang)}; }
        for (int i = gt; i < 2048 * 16; i += NT) { const int pos = i >> 4, k = i & 15; const float inv = (float)exp(-(double)k / 16.0 * log(500000.0)); const float ang = (float)pos * inv;
            r32[i] = (f32x2){(float)cos((double)ang), (float)sin((double)ang)}; }
        for (int i = gt; i < hy::NTWC; i += NT) {
            int lh = 11; while (lh > 1 && i >= hy::twb(lh - 2)) lh -= 2;
            const int hq = 1 << (lh - 1), r = i - hy::twb(lh), second = r >= hq, pos = second ? r - hq : r, idx = second ? (pos << (12 - lh)) : (pos << (11 - lh));
            const double an = 2.0 * 3.14159265358979323846 * (double)idx / 4096.0; tw[i] = (f32x2){(float)cos(an), (float)(-sin(an))}; }
        float* w4t = (float*)(ws + WS_W4T);
        for (int i = gt; i < 2 * 4096 * 64; i += NT) { const int li = i / (4096 * 64), r = i - li * (4096 * 64), j = r >> 12, col = r & 4095;
            w4t[(size_t)li * 4096 * 64 + (size_t)col * 64 + j] = a.in[24][(size_t)li * 64 * 4096 + (size_t)j * 4096 + col]; }
    }
    {
        float* h3 = (float*)(ws + WS_H3);
        for (int t2 = gw; t2 < 2 * 2048; t2 += NGW) {
            const int li = t2 >> 11, t = t2 & 2047, n = F.lane;
            const float* w1 = a.in[17] + li * 33 * 64; const float* b1 = a.in[18] + li * 64; const float* w2 = a.in[19] + li * 64 * 64; const float* b2 = a.in[20] + li * 64;
            const float* w3 = a.in[21] + li * 64 * 64; const float* b3 = a.in[22] + li * 64; const float fr = a.in[23][li * 64 + n];
            const float tt = (float)t / 2047.0f; const float wpos = (6.283185307179586f * (float)t) / 2048.0f;
            float zf = tt;
            if (n >= 1 && n <= 32) { const int k = (n - 1) & 15; const float fb = 1e-4f + (float)k * ((15.0f - 1e-4f) / 15.0f); const float fwv = wpos * fb; zf = (n <= 16) ? cosf(fwv) : -sinf(fwv); }
            float acc = b1[n];
#pragma unroll
            for (int j = 0; j < 33; ++j) acc += __builtin_bit_cast(float, __builtin_amdgcn_readlane(__builtin_bit_cast(int, zf), j)) * w1[j * 64 + n];
            float h = sinf(fr * acc);
            acc = b2[n];
#pragma unroll 8
            for (int j = 0; j < 64; ++j) acc += __builtin_bit_cast(float, __builtin_amdgcn_readlane(__builtin_bit_cast(int, h), j)) * w2[j * 64 + n];
            h = sinf(fr * acc);
            acc = b3[n];
#pragma unroll 8
            for (int j = 0; j < 64; ++j) acc += __builtin_bit_cast(float, __builtin_amdgcn_readlane(__builtin_bit_cast(int, h), j)) * w3[j * 64 + n];
            h = sinf(fr * acc);
            h3[(size_t)t2 * 64 + n] = h;
        }
    }
}

__device__ __forceinline__ void kf_gen(Frame& F) {
    typedef float f32x16 __attribute__((ext_vector_type(16)));
    const int gw = F.vcu * NWAVES + F.wave, NGW = F.G * NWAVES;
    const float* h3 = (const float*)(F.ws + WS_H3); const float* w4t = (const float*)(F.ws + WS_W4T); float* KF = (float*)(F.ws + WS_KF);
    const int r32 = F.lane & 31, hi = F.lane >> 5;
    for (int task = gw; task < 2 * 128 * 8; task += NGW) {
        const int li = task >> 10, ct = (task >> 3) & 127, tg = task & 7;
        f32x4 wa[16];
        { const float* wrow = w4t + ((size_t)li * 4096 + ct * 32 + r32) * 64;
#pragma unroll
          for (int q = 0; q < 16; ++q) wa[q] = *(const GAS f32x4*)(wrow + 4 * q); }
        float nd[16];
#pragma unroll
        for (int r = 0; r < 16; ++r) { const int c = (ct * 32 + (r & 3) + 8 * (r >> 2) + 4 * hi) & 1023;
            const float mind = -3.0701134573253944f, maxd = -15.350567286626972f;
            nd[r] = -fabsf(mind + (float)c * ((maxd - mind) / 1023.0f)) * (1.0f / 2047.0f); }
        f32x4 hb[16];
        { const float* hrow = h3 + ((size_t)li * 2048 + (tg * 8) * 32 + r32) * 64;
#pragma unroll
          for (int q = 0; q < 16; ++q) hb[q] = *(const GAS f32x4*)(hrow + 4 * q); }
#pragma unroll 1
        for (int tt = 0; tt < 8; ++tt) {
            const int t0 = (tg * 8 + tt) * 32, t = t0 + r32;
            f32x16 acc = f32x16{};
#pragma unroll
            for (int q = 0; q < 16; ++q) {
                acc = __builtin_amdgcn_mfma_f32_32x32x2f32(hi ? wa[q][1] : wa[q][0], hi ? hb[q][1] : hb[q][0], acc, 0, 0, 0);
                acc = __builtin_amdgcn_mfma_f32_32x32x2f32(hi ? wa[q][3] : wa[q][2], hi ? hb[q][3] : hb[q][2], acc, 0, 0, 0);
            }
            if (tt < 7) { const float* hrow = h3 + ((size_t)li * 2048 + t + 32) * 64;
#pragma unroll
              for (int q = 0; q < 16; ++q) hb[q] = *(const GAS f32x4*)(hrow + 4 * q); }
            const float tf = (float)t;
#pragma unroll
            for (int r = 0; r < 16; ++r) { const int c = ct * 32 + (r & 3) + 8 * (r >> 2) + 4 * hi;
                KF[((size_t)li * 4096 + c) * 2048 + t] = acc[r] * __expf(tf * nd[r]); }
        }
    }
}

__device__ __forceinline__ void norm_phase(Frame& F, const float* X, const float* g, const float* mod, bf16* H) {
    const int gw = F.vcu * NWAVES + F.wave, NGW = F.G * NWAVES;
    for (int r0 = gw * 4; r0 < M; r0 += NGW * 4) {
        const int b = r0 >> 11; const float* mb = mod + (size_t)b * 6144;
        f32x4 gs[8], sh[8];
#pragma unroll
        for (int j = 0; j < 8; ++j) { const int c = 4 * F.lane + 256 * j; const f32x4 gg = *(const GAS f32x4*)(g + c), sc = *(const GAS f32x4*)(mb + 2048 + c); gs[j] = gg * (sc + 1.0f); sh[j] = *(const GAS f32x4*)(mb + c); }
#pragma unroll 1
        for (int rr = 0; rr < 4; ++rr) {
            const int row = r0 + rr; const float* xr = X + (size_t)row * D + 4 * F.lane;
            f32x4 v[8]; float s = 0.f;
#pragma unroll
            for (int j = 0; j < 8; ++j) { v[j] = *(const GAS f32x4*)(xr + 256 * j); s += (v[j].x * v[j].x + v[j].y * v[j].y) + (v[j].z * v[j].z + v[j].w * v[j].w); }
            const float rstd = 1.0f / sqrtf(wave_sum(s) * (1.0f / D) + RMS_EPS);
            bf16* hr = H + (size_t)row * D + 4 * F.lane;
#pragma unroll
            for (int j = 0; j < 8; ++j) { const f32x4 o = v[j] * rstd * gs[j] + sh[j]; v2u w; w.x = pk2(o.x, o.y); w.y = pk2(o.z, o.w); *(GAS v2u*)(hr + 256 * j) = w; }
        }
    }
}
__device__ __forceinline__ void final_norm_phase(Frame& F, float* X, const float* g) {
    const int gw = F.vcu * NWAVES + F.wave, NGW = F.G * NWAVES;
    f32x4 gs[8];
#pragma unroll
    for (int j = 0; j < 8; ++j) gs[j] = *(const GAS f32x4*)(g + 4 * F.lane + 256 * j);
    for (int row = gw; row < M; row += NGW) {
        float* xr = X + (size_t)row * D + 4 * F.lane;
        f32x4 v[8]; float s = 0.f;
#pragma unroll
        for (int j = 0; j < 8; ++j) { v[j] = *(const GAS f32x4*)(xr + 256 * j); s += (v[j].x * v[j].x + v[j].y * v[j].y) + (v[j].z * v[j].z + v[j].w * v[j].w); }
        const float rstd = 1.0f / sqrtf(wave_sum(s) * (1.0f / D) + RMS_EPS);
#pragma unroll
        for (int j = 0; j < 8; ++j) *(GAS f32x4*)(xr + 256 * j) = v[j] * rstd * gs[j];
    }
}

__device__ __forceinline__ void e3_phase(Frame& F, const bf16* Z, const float* cw  , const float* cb  ) {
    unsigned char* ws = F.ws;
    const int gw = F.vcu * NWAVES + F.wave, NGW = F.G * NWAVES;
    bf16* KR = (bf16*)(ws + WS_KR); const f32x2* r64 = (const f32x2*)(ws + WS_ROPE64);
    for (int rb = gw; rb < M; rb += 4 * NGW) {
        float kr4[4]; f32x2 cs4[4];
#pragma unroll
        for (int i = 0; i < 4; ++i) { const int row = rb + i * NGW; if (row < M) { kr4[i] = bflo((unsigned)Z[(size_t)row * EINP + 768 + F.lane]); cs4[i] = r64[(size_t)(row & 2047) * 32 + (F.lane & 31)]; } }
#pragma unroll
        for (int i = 0; i < 4; ++i) { const int row = rb + i * NGW; if (row < M) {
        const float kr = kr4[i];
        float other; { auto rr = __builtin_amdgcn_permlane32_swap(__float_as_uint(kr), __float_as_uint(kr), false, false); other = __uint_as_float(F.lane < 32 ? rr[1] : rr[0]); }
        const f32x2 cs = cs4[i];
        const float rot = F.lane < 32 ? kr * cs.x - other * cs.y : kr * cs.x + other * cs.y;
        KR[(size_t)row * 64 + F.lane] = (bf16)(pk2(rot, 0.f) & 0xffffu);
        } }
    }
    LAS unsigned* tile = (LAS unsigned*)(F.lds + F.wave * 10240);
    LAS float* wts = (LAS float*)(F.lds + F.wave * 10240 + 8960);
    bf16* UT = (bf16*)(ws + WS_UT);
    for (int item = gw; item < (M / 64) * 48; item += NGW) {
        const int tb = item / 48, cgp = item - tb * 48, tok0 = tb * 64, hc0 = cgp * 64, b = tok0 >> 11, s0 = tok0 & 2047;
#pragma unroll
        for (int i = 0; i < 9; ++i) { const int rl = 8 * i + (F.lane >> 3); if (rl < 66) { const int s = s0 - 1 + rl; v4u x = (v4u){0u, 0u, 0u, 0u};
                if (s >= 0 && s < 2048) x = *(const GAS v4u*)(Z + (size_t)(b * 2048 + s) * EINP + 832 + hc0 + 8 * (F.lane & 7));
                LAS unsigned* d = tile + rl * 33 + 4 * (F.lane & 7); d[0] = x.x; d[1] = x.y; d[2] = x.z; d[3] = x.w; } }
        LDS_WAIT(); asm volatile("" ::: "memory");
        const int part = hc0 >> 10, c0 = hc0 & 1023;
        bf16* up = UT + ((size_t)(part * 4 + b) * 1024 + c0) * 2048 + s0 + F.lane;
        if (F.lane < 32) { const int hcl = hc0 + 2 * F.lane;
            const f32x2 a0 = *(const GAS f32x2*)(cw + hcl), a1 = *(const GAS f32x2*)(cw + 3072 + hcl), a2 = *(const GAS f32x2*)(cw + 6144 + hcl), ab = *(const GAS f32x2*)(cb + hcl);
            *(LAS f32x4*)(wts + F.lane * 8) = (f32x4){a0.x, a1.x, a2.x, ab.x}; *(LAS f32x4*)(wts + F.lane * 8 + 4) = (f32x4){a0.y, a1.y, a2.y, ab.y}; }
        LDS_WAIT(); asm volatile("" ::: "memory");
#pragma unroll 8
        for (int cp = 0; cp < 32; ++cp) {
            const unsigned xm = tile[(F.lane) * 33 + cp], x0 = tile[(F.lane + 1) * 33 + cp], xp = tile[(F.lane + 2) * 33 + cp];
            const f32x4 wx = *(const LAS f32x4*)(wts + cp * 8), wy = *(const LAS f32x4*)(wts + cp * 8 + 4);
            const float y0 = wx[3] + wx[0] * bflo(xm) + wx[1] * bflo(x0) + wx[2] * bflo(xp);
            const float y1 = wy[3] + wy[0] * bfhi(xm) + wy[1] * bfhi(x0) + wy[2] * bfhi(xp);
            const unsigned pk = pk2(y0, y1);
            up[(size_t)(2 * cp) * 2048] = (bf16)(pk & 0xffffu); up[(size_t)(2 * cp + 1) * 2048] = (bf16)(pk >> 16);
        }
        LDS_WAIT(); asm volatile("" ::: "memory");
    }
}
__device__ __forceinline__ void o2b_phase(Frame& F, bf16* Z) {
    const int gw = F.vcu * NWAVES + F.wave, NGW = F.G * NWAVES; const f32x2* r32 = (const f32x2*)(F.ws + WS_ROPE32);
    for (int row = gw; row < M; row += NGW) {
        const int hd = F.lane >> 4, i = F.lane & 15; bf16* p = Z + (size_t)row * NQKV + 2048 + hd * 128 + i;
        const float x1 = bflo((unsigned)p[0]), x2 = bflo((unsigned)p[16]); const f32x2 cs = r32[(size_t)(row & 2047) * 16 + i];
        const unsigned pk = pk2(x1 * cs.x - x2 * cs.y, x2 * cs.x + x1 * cs.y);
        p[0] = (bf16)(pk & 0xffffu); p[16] = (bf16)(pk >> 16);
    }
}

constexpr int PH_FINAL = 42, PH_END = 43;
__global__ void __launch_bounds__(NWAVES * 64, 2) mk_fwd(Args args) {
    extern __shared__ __attribute__((aligned(16))) unsigned char lds[];
    Frame F;
    F.lds = (LAS unsigned char*)lds;
    F.MISC = (volatile LAS unsigned*)(F.lds + MISC_OFF);
    F.tid = threadIdx.x; F.lane = F.tid & 63; F.wave = __builtin_amdgcn_readfirstlane(F.tid >> 6);
    F.G = gridDim.x; { const int bx = blockIdx.x; F.vcu = (F.G % 8 == 0) ? (bx % 8) * (F.G / 8) + bx / 8 : bx; }
    F.ws = args.ws; F.ctl = (gu32*)(args.ws + WS_CTL);
    for (int u = F.tid; u < (LDS_BYTES - LDSCTL_OFF) / 4; u += NWAVES * 64) ((LAS unsigned*)(F.lds + LDSCTL_OFF))[u] = 0u;
    __syncthreads();
    XcdBarrier bar; bar.bar = (unsigned*)(F.ctl + CW_BAR); bar.x = 0; bar.st = nullptr;
    if (!MK_MULTI) bar = xcd_barrier_post((unsigned*)(F.ctl + CW_BAR), F.MISC + 8);
    const int lo = args.ph_lo, hi = args.ph_hi;
    unsigned char* ws = args.ws;
#define IN(k) (lo <= (k) && (k) < hi)
#if defined(SKIP_GEMM) || defined(SKIP_G1)
#define GEMM_CALL_G1 if (0)
#else
#define GEMM_CALL_G1
#endif
#if defined(SKIP_GEMM) || defined(SKIP_G3A)
#define GEMM_CALL_G3A if (0)
#else
#define GEMM_CALL_G3A
#endif
#if defined(SKIP_GEMM) || defined(SKIP_G3B)
#define GEMM_CALL_G3B if (0)
#else
#define GEMM_CALL_G3B
#endif
#if defined(SKIP_GEMM) || defined(SKIP_G5)
#define GEMM_CALL_G5 if (0)
#else
#define GEMM_CALL_G5
#endif
#if defined(SKIP_GEMM) || defined(SKIP_G7)
#define GEMM_CALL_G7 if (0)
#else
#define GEMM_CALL_G7
#endif
#if defined(SKIP_GEMM) || defined(SKIP_G8)
#define GEMM_CALL_G8 if (0)
#else
#define GEMM_CALL_G8
#endif
#define RELAUNDER() do { int w_ = F.wave, c_ = F.vcu, g_ = F.G; asm volatile("" : "+s"(w_), "+s"(c_), "+s"(g_)); F.wave = w_; F.vcu = c_; F.G = g_; { GAS unsigned char* q_ = (GAS unsigned char*)args.ws; asm volatile("" : "+s"(q_)); ws = (unsigned char*)q_; F.ws = ws; }     int l_; asm volatile("v_mbcnt_lo_u32_b32 %0, -1, 0\n\tv_mbcnt_hi_u32_b32 %0, -1, %0" : "=v"(l_)); F.lane = l_; F.tid = w_ * 64 + l_; } while (0)
#define SEAM() do { if (!MK_MULTI) { REP(BAR) xcd_barrier(bar, F.tid == 0); } } while (0)
    float* X = args.out;
#define H ((bf16*)(ws + WS_H))
#define Z ((bf16*)(ws + WS_Z))
#define MIX ((bf16*)(ws + WS_MIX))
#define HID ((bf16*)(ws + WS_HID))
#define MOD ((const float*)(ws + CTL_MOD_OFF))
#define ROWSS ((float*)(ws + CTL_ROWSS_OFF))
#define ROWSS2 ((float*)(ws + CTL_ROWSS2_OFF))
#define BIAS7 ((const float*)(ws + CTL_BIAS7_OFF))
#define BIAS1 ((const float*)(ws + CTL_BIAS1_OFF))

#ifndef SKIP_P0
    if (IN(0)) { RELAUNDER(); p0_ada(F, args); p0_tables(F, args); SEAM(); }
    if (IN(1)) { RELAUNDER(); p0_convert(F, args);
#ifndef SKIP_NORM
        REP(NORM) norm_phase(F, args.in[0], args.in[4], MOD, H);
#endif
#ifndef SKIP_KF
        REP(KF) kf_gen(F);
#endif
        SEAM(); }
#endif

#pragma unroll 1
    for (int l = 0; l < DEPTH; ++l) {
        const int base = 2 + 10 * l, i2 = l >> 1; const bool even = (l & 1) == 0;
        const float* xin = (l == 0) ? args.in[0] : X;
        if (IN(base + 1)) { RELAUNDER();
            const int N = even ? EINP : NQKV;
            const bf16* Wt = even ? (const bf16*)(ws + WS_WEIN) + (size_t)i2 * EINP * D : (const bf16*)(ws + WS_WQKV) + (size_t)i2 * NQKV * D;
            pg8::Gemm g{H, Wt, M, N, D}; pg8::StaticOrder S; S.init(M, N, F.G, (int)blockIdx.x);
            pg8::EpiBf16<0> E{Z, N, l > 0 ? ROWSS + (size_t)(2 * l) * M : nullptr, BIAS1 + (size_t)l * 4 * 4096, 4096, 1.0f / 2048.0f, even ? ROWSS2 + (size_t)(2 * i2) * M : nullptr, ROWSS2 + (size_t)(2 * i2 + 1) * M, even ? nullptr : (const float*)(ws + WS_ROPE32)};
            REP(G1) GEMM_CALL_G1 pg8::gemm_phase<pg8::EpiBf16<0>, pg8::StaticOrder, PG8_ALIGN, PG8_SP2>(F.lds, g, S, E, F.tid);
#ifndef SKIP_KH
            if (l == 1 && (int)blockIdx.x >= F.G / 2) {
                const int nh = F.G - F.G / 2;
                asm volatile("s_waitcnt vmcnt(0) lgkmcnt(0)\n\ts_barrier" ::: "memory");
                hy::load_tw(F.lds, (const hy::f32x2*)(ws + WS_TW), F.tid);
                HY_SYNC();
                for (int t = (int)blockIdx.x - F.G / 2; t < 512; t += nh) hy::khat_task(F.lds, (const float*)(ws + WS_KF), (hy::f32x2*)(ws + WS_KH), 1, t, F.tid);
            }
#endif
            SEAM();
        }
        if (even && IN(base + 2)) { RELAUNDER();
          REP(G3) {
            { pg8::Gemm g{Z, (const bf16*)(ws + WS_WUQ) + (size_t)i2 * NQ_MLA * QL_W, M, NQ_MLA, QL_W, EINP}; pg8::StaticOrder S; S.init(M, NQ_MLA, F.G, (int)blockIdx.x);
              pg8::EpiBf16<0> E{(bf16*)(ws + WS_Q), NQ_MLA, ROWSS2 + (size_t)(2 * i2) * M, nullptr, 0, 1.0f / 512.0f, nullptr, nullptr, nullptr};
              GEMM_CALL_G3A pg8::gemm_phase<pg8::EpiBf16<0>, pg8::StaticOrder, PG8_ALIGN, PG8_SP2>(F.lds, g, S, E, F.tid); }
            __syncthreads();
            { pg8::Gemm g{Z + 512, (const bf16*)(ws + WS_WUKV) + (size_t)i2 * NKV_MLA * KVL_W, M, NKV_MLA, KVL_W, EINP}; pg8::StaticOrder S; S.init(M, NKV_MLA, F.G, (int)blockIdx.x);
              pg8::EpiBf16<0> E{(bf16*)(ws + WS_KV), NKV_MLA, ROWSS2 + (size_t)(2 * i2 + 1) * M, nullptr, 0, 1.0f / 256.0f, nullptr, nullptr, nullptr};
              GEMM_CALL_G3B pg8::gemm_phase<pg8::EpiBf16<0>, pg8::StaticOrder, PG8_ALIGN, PG8_SP2>(F.lds, g, S, E, F.tid); }
            __syncthreads(); }
#ifndef SKIP_THIN
            REP(E3) e3_phase(F, Z, args.in[15] + (size_t)i2 * 3 * 3072, args.in[16] + (size_t)i2 * 3072);
#endif
#ifndef SKIP_KH
            if (l == 0) {
                asm volatile("s_waitcnt vmcnt(0) lgkmcnt(0)\n\ts_barrier" ::: "memory");
                hy::load_tw(F.lds, (const hy::f32x2*)(ws + WS_TW), F.tid);
                HY_SYNC();
                REP(KH) for (int t = F.vcu; t < 512; t += F.G) hy::khat_task(F.lds, (const float*)(ws + WS_KF), (hy::f32x2*)(ws + WS_KH), 0, t, F.tid);
            }
#endif
            SEAM();
        }
        if (IN(base + 4)) { RELAUNDER();
            if (even) {
                const bf16* Qb = (const bf16*)(ws + WS_Q); const bf16* KVb = (const bf16*)(ws + WS_KV); const bf16* KRb = (const bf16*)(ws + WS_KR);
                const float scale = 0.07216878364870322f;
#ifndef SKIP_MLA
                REP(MLA) for (int u = F.vcu; u < 256; u += F.G) {
                    const int b = u >> 6, h = (u >> 3) & 7, qb = u & 7; const size_t rb = (size_t)b * SEQ;
                    att::attn_unit<192, 0>(F.lds, Qb + rb * NQ_MLA + h * 192, NQ_MLA, KVb + rb * NKV_MLA + h * 256, NKV_MLA, KRb + rb * 64, KVb + rb * NKV_MLA + h * 256 + 128, NKV_MLA,
                                           MIX + rb * D + h * 128, (const att::f32x2*)(ws + WS_ROPE64), qb * 256, 0, 32, scale * 1.4426950408889634f, 8.0f / scale, nullptr, F.tid);
                }
#endif
#ifndef SKIP_HY
                asm volatile("s_waitcnt vmcnt(0) lgkmcnt(0)\n\ts_barrier" ::: "memory");
                hy::load_tw(F.lds, (const hy::f32x2*)(ws + WS_TW), F.tid);
                HY_SYNC();
                REP(HY) for (int u = F.vcu; u < 256; u += F.G)
                    hy::hyena_unit(F.lds, (const unsigned short*)(ws + WS_UT), (const hy::f32x2*)(ws + WS_KH) + (size_t)i2 * 2 * 1024 * 4096, args.in[25] + (size_t)i2 * 2 * 1024, MIX, 4 * u, F.tid);
#endif
            } else {
                const float scale = 0.08838834764831845f;
#ifndef SKIP_GQA
                REP(GQA) for (int u = F.vcu; u < 512; u += F.G) {
                    const int b = u >> 7, kvh = (u >> 5) & 3, qblk = u & 31; const size_t rb = (size_t)b * SEQ;
                    const int tlo = qblk - 2 < 0 ? 0 : qblk - 2, thi = qblk + 3 > 32 ? 32 : qblk + 3;
                    att::attn_unit<128, 1>(F.lds, Z + rb * NQKV + kvh * 512, NQKV, Z + rb * NQKV + 2048 + kvh * 128, NQKV, nullptr, Z + rb * NQKV + 2560 + kvh * 128, NQKV,
                                           MIX + rb * D + kvh * 512, (const att::f32x2*)(ws + WS_ROPE32), qblk * 64, tlo, thi, scale * 1.4426950408889634f, 8.0f / scale,
                                           args.in[28] + i2 * 16 + kvh * 4, F.tid);
                }
#endif
            }
            SEAM();
        }
        if (IN(base + 5)) { RELAUNDER();
            const bf16* Wt = even ? (const bf16*)(ws + WS_WEOUT) + (size_t)i2 * D * D : (const bf16*)(ws + WS_WO) + (size_t)i2 * D * D;
            pg8::Gemm g{MIX, Wt, M, D, D}; pg8::StaticOrder S; S.init(M, D, F.G, (int)blockIdx.x);
            REP(G5) { pg8::EpiResGate E{xin, rep_ == PROBE_G5 ? X : (float*)(ws + WS_END), MOD + (size_t)(2 * l) * 4 * 6144 + 4096,
                rep_ == PROBE_G5 ? H : nullptr, args.in[7] + l * D, MOD + (size_t)(2 * l + 1) * 4 * 6144 + 2048, ROWSS + (size_t)(2 * l + 1) * M};
            GEMM_CALL_G5 pg8::gemm_phase<pg8::EpiResGate, pg8::StaticOrder, PG8_ALIGN, PG8_SP2>(F.lds, g, S, E, F.tid); }
            SEAM();
        }
        if (IN(base + 7)) { RELAUNDER();
            pg8::Gemm g{H, (const bf16*)(ws + WS_WIN) + (size_t)l * DFF * D, M, DFF, D}; pg8::StaticOrder S; S.init(M, DFF, F.G, (int)blockIdx.x);
            pg8::EpiBf16<2> E{HID, DFF, ROWSS + (size_t)(2 * l + 1) * M, BIAS7 + (size_t)l * 4 * 8192, 8192, 1.0f / 2048.0f, nullptr, nullptr, nullptr};
            REP(G7) GEMM_CALL_G7 pg8::gemm_phase<pg8::EpiBf16<2>, pg8::StaticOrder, PG8_ALIGN, PG8_SP2>(F.lds, g, S, E, F.tid);
#if PROBE_GK
            { pg8::Gemm g2{H, (const bf16*)(ws + WS_WIN) + (size_t)l * DFF * D, M, DFF, PROBE_GK};
              pg8::EpiBf16<2> E2{(bf16*)(ws + WS_END), DFF, ROWSS + (size_t)(2 * l + 1) * M, BIAS7 + (size_t)l * 4 * 8192, 8192, 1.0f / 2048.0f, nullptr, nullptr, nullptr};
              pg8::gemm_phase<pg8::EpiBf16<2>, pg8::StaticOrder, PG8_ALIGN, PG8_SP2>(F.lds, g2, S, E2, F.tid); }
#endif
            SEAM();
        }
        if (IN(base + 8)) { RELAUNDER();
            pg8::Gemm g{HID, (const bf16*)(ws + WS_WOUT) + (size_t)l * D * DFF, M, D, DFF}; pg8::StaticOrder S; S.init(M, D, F.G, (int)blockIdx.x);
            REP(G8) { pg8::EpiResGate E{X, rep_ == PROBE_G8 ? X : (float*)(ws + WS_END), MOD + (size_t)(2 * l + 1) * 4 * 6144 + 4096,
                (l < DEPTH - 1) ? (rep_ == PROBE_G8 ? H : (bf16*)(ws + WS_END + 64 * MiB)) : nullptr, args.in[4] + (l + 1 < DEPTH ? l + 1 : l) * D, MOD + (size_t)(2 * l + 2 < 8 ? 2 * l + 2 : 0) * 4 * 6144 + 2048, rep_ == PROBE_G8 ? ROWSS + (size_t)(2 * l + 2 < 8 ? 2 * l + 2 : 0) * M : (float*)(ws + WS_END + 96 * MiB)};
            GEMM_CALL_G8 pg8::gemm_phase<pg8::EpiResGate, pg8::StaticOrder, PG8_ALIGN, PG8_SP2>(F.lds, g, S, E, F.tid); }
            SEAM();
        }
    }
    if (IN(PH_FINAL)) { RELAUNDER(); final_norm_phase(F, X, args.in[30]); }
#undef IN
#undef SEAM
#undef H
#undef Z
#undef MIX
#undef HID
#undef MOD
#undef ROWSS
#undef ROWSS2
#undef BIAS7
#undef BIAS1
}

extern "C" void kernel_launch(void* const* d_in, const int* in_sizes, int n_in, void* d_out, int out_size, void* d_ws, size_t ws_size, hipStream_t stream) {
    static int grid = 0;
    if (grid == 0) {
        if (n_in != 31 || in_sizes[0] != M * D || out_size != M * D || ws_size < WS_END) {
            fprintf(stderr, "kernel_launch: shape mismatch (n_in %d, in0 %d, out %d, ws %zu, need %zu); nothing launched\n", n_in, n_in > 0 ? in_sizes[0] : -1, out_size, ws_size, (size_t)WS_END); grid = -1; return; }
        int dev = 0, cus = 0, per_cu = 0;
        if (hipGetDevice(&dev) != hipSuccess || hipDeviceGetAttribute(&cus, hipDeviceAttributeMultiprocessorCount, dev) != hipSuccess) { fprintf(stderr, "kernel_launch: device query failed\n"); grid = -1; return; }
        if (hipFuncSetAttribute((const void*)mk_fwd, hipFuncAttributeMaxDynamicSharedMemorySize, LDS_BYTES) != hipSuccess) { fprintf(stderr, "kernel_launch: hipFuncSetAttribute failed\n"); grid = -1; return; }
        if (hipOccupancyMaxActiveBlocksPerMultiprocessor(&per_cu, (const void*)mk_fwd, NWAVES * 64, LDS_BYTES) != hipSuccess || per_cu < 1)
            fprintf(stderr, "kernel_launch: note: occupancy query reports %d workgroups per CU\n", per_cu);
        (void)hipGetLastError();
        grid = cus;
    }
    if (grid < 0) return;
    if (hipMemsetAsync((char*)d_ws + WS_CTL, 0, CTL_ZERO_BYTES, stream) != hipSuccess) { fprintf(stderr, "kernel_launch: memset failed\n"); return; }
    Args a{};
    for (int i = 0; i < 31; ++i) a.in[i] = (const float*)d_in[i];
    a.out = (float*)d_out; a.ws = (unsigned char*)d_ws;
#if MK_MULTI
    for (int p = 0; p < PH_END; ++p) {
        if (p >= 2 && p <= 41) { const int k = (p - 2) % 10, l = (p - 2) / 10; if (k == 9 || k == 6 || k == 0 || k == 3 || (k == 2 && (l & 1))) continue; }
        a.ph_lo = p; a.ph_hi = p + 1;
        hipLaunchKernelGGL(mk_fwd, dim3(grid), dim3(NWAVES * 64), LDS_BYTES, stream, a);
    }
#else
    a.ph_lo = 0; a.ph_hi = PH_END;
    hipLaunchKernelGGL(mk_fwd, dim3(grid), dim3(NWAVES * 64), LDS_BYTES, stream, a);
#endif
    const hipError_t le = hipPeekAtLastError();
    if (le != hipSuccess) fprintf(stderr, "kernel_launch: launch failed: %s (grid %d)\n", hipGetErrorName(le), grid);
}
```
